# Optimizing an MI355X kernel written in HIP

```python
import math
import jax, jax.numpy as jnp
from jax import lax
import numpy as np

D_MODEL = 1024
BATCH = 16
SEQ = 2048
DEPTH = 2

RET_HEADS = 8
RET_DK = 64
RET_DV = 128
RET_CHUNK = 128
RET_THETA = 10000.0
DSA_HEADS = 8
DSA_DIM = 64
ROT_DIM = DSA_DIM // 4
ROPE_THETA = 500000.0
IDX_HEADS = 4
IDX_DIM = 64
TOPK_MAX = 256
Q_BLOCK = 128
RWKV_HEADS = 8
RWKV_DIM = 64
DECAY_LORA = 64
AAA_LORA = 64
GATE_LORA = 128
RWKV_GN_EPS = 64e-5
D_FF = 2816
RMS_EPS = 1e-6
NEG_INF = -1e30
N_BRANCH = 3

RET_WIDTH = RET_HEADS * RET_DV
DSA_WIDTH = DSA_HEADS * DSA_DIM
RWKV_WIDTH = RWKV_HEADS * RWKV_DIM
RET_SIZES = (RET_HEADS * RET_DK, RET_HEADS * RET_DK, RET_HEADS * RET_DV, RET_HEADS * RET_DV)
DSA_SIZES = (DSA_HEADS * DSA_DIM, DSA_DIM, DSA_DIM, IDX_HEADS * IDX_DIM, IDX_DIM, IDX_HEADS)
RWKV_SIZES = (RWKV_WIDTH, RWKV_WIDTH, RWKV_WIDTH, DECAY_LORA, AAA_LORA, GATE_LORA)
GATE_COLS = N_BRANCH * D_MODEL
GROUP_SIZES = (sum(RET_SIZES), sum(DSA_SIZES), sum(RWKV_SIZES), GATE_COLS)
N_IN = sum(GROUP_SIZES)

kernel_name = 'hybrid_retention_dsa_rwkv7_macaron'


def split_cols(a, sizes):
    cuts = [int(c) for c in np.cumsum(sizes)[:-1]]
    return jnp.split(a, cuts, axis=-1)


def rms_norm(x, g):
    xf = x.astype(jnp.float32)
    y = xf * lax.rsqrt(jnp.mean(xf * xf, axis=-1, keepdims=True) + RMS_EPS)
    return (y * g.astype(jnp.float32)).astype(x.dtype)


def swiglu(h, w_in, w_out):
    gate, up = jnp.split(h @ w_in, 2, axis=-1)
    return (jax.nn.silu(gate) * up) @ w_out


def rope_tables(seq, rot_dim, theta):
    inv_freq = theta ** (-jnp.arange(0, rot_dim, 2, dtype=jnp.float32) / rot_dim)
    ang = jnp.arange(seq, dtype=jnp.float32)[:, None] * inv_freq[None, :]
    return jnp.cos(ang), jnp.sin(ang)


def apply_rope(x, cos, sin):
    xf = x.astype(jnp.float32)
    x1, x2 = jnp.split(xf, 2, axis=-1)
    return jnp.concatenate([x1 * cos - x2 * sin, x1 * sin + x2 * cos], axis=-1).astype(x.dtype)


def partial_rope(x, cos, sin):
    return jnp.concatenate([apply_rope(x[..., :ROT_DIM], cos, sin), x[..., ROT_DIM:]], axis=-1)


def token_shift(p, mu):
    prev = jnp.pad(p[:, :-1], ((0, 0), (1, 0), (0, 0)))
    return p + mu * (prev - p)


def retention(q, k, v, g, cos, sin):
    B, T = q.shape[:2]
    n_chunks = T // RET_CHUNK
    f32 = jnp.float32
    q = apply_rope(q, cos[:, None], sin[:, None]).astype(f32)
    k = apply_rope(k, cos[:, None], sin[:, None]).astype(f32) * (RET_DK ** -0.5)
    log_gamma = jnp.log(1.0 - 2.0 ** (-5.0 - jnp.arange(RET_HEADS, dtype=f32)))
    pos = jnp.arange(RET_CHUNK, dtype=f32)
    rel = pos[:, None] - pos[None, :]
    decay_mask = jnp.where(rel >= 0, jnp.exp(log_gamma[:, None, None] * jnp.maximum(rel, 0.0)), 0.0)
    q_decay = jnp.exp(log_gamma[:, None] * (pos + 1.0))[None, :, :, None]
    k_decay = jnp.exp(log_gamma[:, None] * (RET_CHUNK - 1.0 - pos))[None, :, :, None]
    chunk_decay = jnp.exp(log_gamma * RET_CHUNK)[None, :, None, None]

    def to_chunks(a):
        return a.reshape(B, n_chunks, RET_CHUNK, RET_HEADS, a.shape[-1]).transpose(1, 0, 3, 2, 4)

    def step(state, inp):
        qc, kc, vc = inp
        scores = jnp.einsum('bhid,bhjd->bhij', qc, kc) * decay_mask
        out = jnp.einsum('bhij,bhjv->bhiv', scores, vc) + jnp.einsum('bhid,bhdv->bhiv', qc, state) * q_decay
        state = state * chunk_decay + jnp.einsum('bhjd,bhjv->bhdv', kc * k_decay, vc)
        return state, out

    state0 = jnp.zeros((B, RET_HEADS, RET_DK, RET_DV), f32)
    _, o = lax.scan(step, state0, (to_chunks(q), to_chunks(k), to_chunks(v.astype(f32))))
    o = o.transpose(1, 0, 3, 2, 4).reshape(B, T, RET_HEADS, RET_DV)
    o = o * lax.rsqrt(jnp.mean(o * o, axis=-1, keepdims=True) + RMS_EPS)
    return (jax.nn.silu(g.astype(f32)) * o.reshape(B, T, RET_WIDTH)).astype(g.dtype)


def sparse_attention(q, k, v, q_idx, k_idx, w_idx, cos, sin):
    B, T = q.shape[:2]
    n_blocks = T // Q_BLOCK
    k_top = min(TOPK_MAX, T // 4)
    f32 = jnp.float32
    q = partial_rope(q, cos[:, None], sin[:, None])
    k = partial_rope(k, cos, sin)
    q_idx = partial_rope(q_idx, cos[:, None], sin[:, None]).astype(f32)
    k_idx = partial_rope(k_idx, cos, sin).astype(f32)
    w_idx = w_idx.astype(f32) * (IDX_HEADS ** -0.5)
    key_pos = jnp.arange(T, dtype=jnp.int32)
    gather = jax.vmap(lambda table, idx: table[idx])

    def to_blocks(a):
        return jnp.moveaxis(a.reshape((B, n_blocks, Q_BLOCK) + a.shape[2:]), 1, 0)

    def one_block(inp):
        qb, qib, wb, start = inp
        q_pos = start + jnp.arange(Q_BLOCK, dtype=jnp.int32)
        rel = jnp.einsum('bqhd,bkd->bqhk', qib, k_idx) * (IDX_DIM ** -0.5)
        index_score = jnp.einsum('bqh,bqhk->bqk', wb, jax.nn.relu(rel))
        causal = key_pos[None, :] <= q_pos[:, None]
        index_score = jnp.where(causal[None], index_score, NEG_INF)
        _, sel = lax.top_k(index_score, k_top)
        valid = sel <= q_pos[None, :, None]
        k_sel = gather(k, sel)
        v_sel = gather(v, sel)
        logits = jnp.einsum('bqhd,bqkd->bhqk', qb, k_sel).astype(f32) * (DSA_DIM ** -0.5)
        logits = jnp.where(valid[:, None], logits, NEG_INF)
        p = jax.nn.softmax(logits, axis=-1)
        return jnp.einsum('bhqk,bqkd->bqhd', p.astype(v.dtype), v_sel)

    starts = jnp.arange(n_blocks, dtype=jnp.int32) * Q_BLOCK
    out = lax.map(one_block, (to_blocks(q), to_blocks(q_idx), to_blocks(w_idx), starts))
    return jnp.moveaxis(out, 0, 1).reshape(B, T, DSA_WIDTH)


def rwkv7_time_mix(p, mu, w0, w2, a0, a2, g2, k_k, k_a, r_k, ln_w, ln_b):
    B, T = p.shape[:2]
    f32 = jnp.float32
    r, k, v, w_lr, a_lr, g_lr = split_cols(token_shift(p, mu), RWKV_SIZES)
    log_decay = -jax.nn.softplus(-(w0 + jnp.tanh(w_lr) @ w2).astype(f32)) - 0.5
    decay = jnp.exp(-jnp.exp(log_decay))
    a = jax.nn.sigmoid((a0 + a_lr @ a2).astype(f32))
    g = jax.nn.sigmoid(g_lr) @ g2

    def heads(t):
        return t.astype(f32).reshape(B, T, RWKV_HEADS, RWKV_DIM)

    r_h, v_h, decay_h, a_h = heads(r), heads(v), heads(decay), heads(a)
    kk = heads(k * k_k)
    kk = kk / jnp.maximum(jnp.sqrt(jnp.sum(kk * kk, axis=-1, keepdims=True)), 1e-12)
    k_h = heads(k) * (1.0 + (a_h - 1.0) * k_a.astype(f32).reshape(RWKV_HEADS, RWKV_DIM))

    def step(S, inp):
        r_t, w_t, k_t, v_t, kk_t, a_t = inp
        sa = jnp.einsum('bhvk,bhk->bhv', S, -kk_t)
        S = S * w_t[:, :, None, :] + sa[..., None] * (kk_t * a_t)[:, :, None, :] + v_t[..., None] * k_t[:, :, None, :]
        return S, jnp.einsum('bhvk,bhk->bhv', S, r_t)

    S0 = jnp.zeros((B, RWKV_HEADS, RWKV_DIM, RWKV_DIM), f32)
    xs = tuple(jnp.moveaxis(t, 1, 0) for t in (r_h, decay_h, k_h, v_h, kk, a_h))
    _, y = lax.scan(step, S0, xs)
    y = jnp.moveaxis(y, 0, 1)
    mean = jnp.mean(y, axis=-1, keepdims=True)
    var = jnp.mean(jnp.square(y - mean), axis=-1, keepdims=True)
    y = ((y - mean) * lax.rsqrt(var + RWKV_GN_EPS)).reshape(B, T, RWKV_WIDTH)
    y = y * ln_w.astype(f32) + ln_b.astype(f32)
    bonus = jnp.sum(r_h * k_h * r_k.astype(f32), axis=-1, keepdims=True) * v_h
    y = y + bonus.reshape(B, T, RWKV_WIDTH)
    return (y * g.astype(f32)).astype(p.dtype)


def hybrid_mixer(h, w_in, rwkv_mu, rwkv_w0, rwkv_w2, rwkv_a0, rwkv_a2, rwkv_g2, rwkv_k_k, rwkv_k_a,
                 rwkv_r_k, rwkv_ln_w, rwkv_ln_b, p_ret, p_dsa, p_rwkv, w_out, ret_cs, rot_cs):
    B, T, _ = h.shape
    proj = h @ w_in
    ret_p, dsa_p, rwkv_p, gate_p = split_cols(proj, GROUP_SIZES)
    rq, rk, rv, rg = split_cols(ret_p, RET_SIZES)
    y_ret = retention(rq.reshape(B, T, RET_HEADS, RET_DK), rk.reshape(B, T, RET_HEADS, RET_DK),
                      rv.reshape(B, T, RET_HEADS, RET_DV), rg, ret_cs[0], ret_cs[1])
    dq, dk, dv, qi, ki, wi = split_cols(dsa_p, DSA_SIZES)
    y_dsa = sparse_attention(dq.reshape(B, T, DSA_HEADS, DSA_DIM), dk, dv,
                             qi.reshape(B, T, IDX_HEADS, IDX_DIM), ki, wi, rot_cs[0], rot_cs[1])
    y_rwkv = rwkv7_time_mix(rwkv_p, rwkv_mu, rwkv_w0, rwkv_w2, rwkv_a0, rwkv_a2, rwkv_g2,
                            rwkv_k_k, rwkv_k_a, rwkv_r_k, rwkv_ln_w, rwkv_ln_b)
    g_ret, g_dsa, g_rwkv = jnp.split(jax.nn.sigmoid(gate_p), N_BRANCH, axis=-1)
    merged = g_ret * (y_ret @ p_ret) + g_dsa * (y_dsa @ p_dsa) + g_rwkv * (y_rwkv @ p_rwkv)
    return merged @ w_out


def setup_inputs(seed: int = 0) -> dict:
    key = jax.random.key(seed)
    ks = iter(jax.random.split(key, 32))
    L, D = DEPTH, D_MODEL

    def normal(shape, scale):
        return jax.random.normal(next(ks), shape, jnp.float32) * scale

    def gain(shape):
        return 1.0 + normal(shape, 0.02)

    decay_base = jnp.tile(jnp.linspace(-6.0, 1.0, RWKV_DIM, dtype=jnp.float32), RWKV_HEADS)
    return {
        'x': normal((BATCH, SEQ, D), 1.0),
        'norm_ffa': gain((L, D)),
        'ffa_w_in': normal((L, D, 2 * D_FF), D ** -0.5),
        'ffa_w_out': normal((L, D_FF, D), D_FF ** -0.5),
        'norm_mix': gain((L, D)),
        'w_in': normal((L, D, N_IN), D ** -0.5),
        'rwkv_mu': jax.random.uniform(next(ks), (L, sum(RWKV_SIZES)), jnp.float32, 0.05, 0.95),
        'rwkv_w0': decay_base[None, :] + normal((L, RWKV_WIDTH), 0.1),
        'rwkv_w2': normal((L, DECAY_LORA, RWKV_WIDTH), 0.1 * DECAY_LORA ** -0.5),
        'rwkv_a0': normal((L, RWKV_WIDTH), 0.1),
        'rwkv_a2': normal((L, AAA_LORA, RWKV_WIDTH), 0.5 * AAA_LORA ** -0.5),
        'rwkv_g2': normal((L, GATE_LORA, RWKV_WIDTH), GATE_LORA ** -0.5),
        'rwkv_k_k': 0.85 + normal((L, RWKV_WIDTH), 0.02),
        'rwkv_k_a': 1.0 + normal((L, RWKV_WIDTH), 0.02),
        'rwkv_r_k': normal((L, RWKV_HEADS, RWKV_DIM), 0.1),
        'rwkv_ln_w': gain((L, RWKV_WIDTH)),
        'rwkv_ln_b': normal((L, RWKV_WIDTH), 0.02),
        'p_ret': normal((L, RET_WIDTH, D), RET_WIDTH ** -0.5),
        'p_dsa': normal((L, DSA_WIDTH, D), DSA_WIDTH ** -0.5),
        'p_rwkv': normal((L, RWKV_WIDTH, D), RWKV_WIDTH ** -0.5),
        'w_out': normal((L, D, D), D ** -0.5),
        'norm_ffb': gain((L, D)),
        'ffb_w_in': normal((L, D, 2 * D_FF), D ** -0.5),
        'ffb_w_out': normal((L, D_FF, D), D_FF ** -0.5),
        'norm_final': gain((D,)),
    }


def reference(x, norm_ffa, ffa_w_in, ffa_w_out, norm_mix, w_in, rwkv_mu, rwkv_w0, rwkv_w2, rwkv_a0,
              rwkv_a2, rwkv_g2, rwkv_k_k, rwkv_k_a, rwkv_r_k, rwkv_ln_w, rwkv_ln_b, p_ret, p_dsa, p_rwkv,
              w_out, norm_ffb, ffb_w_in, ffb_w_out, norm_final):
    T = x.shape[1]
    ret_cs = rope_tables(T, RET_DK, RET_THETA)
    rot_cs = rope_tables(T, ROT_DIM, ROPE_THETA)
    for l in range(DEPTH):
        h = rms_norm(x, norm_ffa[l])
        x = x + 0.5 * swiglu(h, ffa_w_in[l], ffa_w_out[l])
        h = rms_norm(x, norm_mix[l])
        x = x + hybrid_mixer(h, w_in[l], rwkv_mu[l], rwkv_w0[l], rwkv_w2[l], rwkv_a0[l], rwkv_a2[l],
                             rwkv_g2[l], rwkv_k_k[l], rwkv_k_a[l], rwkv_r_k[l], rwkv_ln_w[l], rwkv_ln_b[l],
                             p_ret[l], p_dsa[l], p_rwkv[l], w_out[l], ret_cs, rot_cs)
        h = rms_norm(x, norm_ffb[l])
        x = x + 0.5 * swiglu(h, ffb_w_in[l], ffb_w_out[l])
    return rms_norm(x, norm_final)
```

```cpp
#include <hip/hip_runtime.h>
#include <cstdio>
#include <cstdint>
#include <cmath>

#define DI __device__ __forceinline__
#define GAS __attribute__((address_space(1)))
#define LAS __attribute__((address_space(3)))
typedef unsigned short bf16;
typedef short bf16x8 __attribute__((ext_vector_type(8)));
typedef float f32x2 __attribute__((ext_vector_type(2)));
typedef float f32x4 __attribute__((ext_vector_type(4)));
typedef float f32x16 __attribute__((ext_vector_type(16)));
typedef unsigned u32x2 __attribute__((ext_vector_type(2)));
typedef unsigned u32x4 __attribute__((ext_vector_type(4)));
typedef LAS unsigned char* ldsp;

constexpr int BATCH = 16, T = 2048, D = 1024, M = BATCH * T, DEPTH = 2, DFF = 2816;
constexpr int NG = 4, BG = BATCH / NG, MG = BG * T;
constexpr int NPROJ = 9216;
constexpr int C_RQ = 0, C_RK = 512, C_RV = 1024, C_RG = 2048;
constexpr int C_DQ = 3072, C_DK = 3584, C_DV = 3648, C_DQI = 3712, C_DKI = 3968, C_DWI = 4032;
constexpr int C_RW = 4096;
constexpr int C_GATE = 5888;
constexpr float RMS_EPS = 1e-6f;
constexpr float NEG_BIG = -1e30f;

DI float bf2f(unsigned b) { return __uint_as_float(b << 16); }
DI unsigned pk2(float lo, float hi) { typedef __bf16 b2 __attribute__((ext_vector_type(2))); f32x2 v = {lo, hi}; b2 b = __builtin_convertvector(v, b2); return __builtin_bit_cast(unsigned, b); }
DI bf16 f2bf(float f) { return (bf16)(pk2(f, 0.f) & 0xffffu); }
typedef _Float16 half8 __attribute__((ext_vector_type(8)));
DI unsigned pkh2(float lo, float hi) { typedef _Float16 h2 __attribute__((ext_vector_type(2))); f32x2 v = {lo, hi}; h2 h = __builtin_convertvector(v, h2); return __builtin_bit_cast(unsigned, h); }
DI float hlo_f(unsigned w) { typedef _Float16 h2 __attribute__((ext_vector_type(2))); return (float)__builtin_bit_cast(h2, w)[0]; }
DI float hhi_f(unsigned w) { typedef _Float16 h2 __attribute__((ext_vector_type(2))); return (float)__builtin_bit_cast(h2, w)[1]; }
#define GEMM_MFMA16(b, a, c) __builtin_amdgcn_mfma_f32_16x16x32_f16(__builtin_bit_cast(half8, (b)), __builtin_bit_cast(half8, (a)), (c), 0, 0, 0)
DI float lo_f(unsigned w) { return __uint_as_float(w << 16); }
DI float hi_f(unsigned w) { return __uint_as_float(w & 0xffff0000u); }
DI float sigmoidf_(float x) { return __builtin_amdgcn_rcpf(1.f + __expf(-x)); }
DI float siluf_(float x) { return x * sigmoidf_(x); }
DI float ex2(float x) { return __builtin_amdgcn_exp2f(x); }
DI float tanhf_(float x) { return 1.f - 2.f * __builtin_amdgcn_rcpf(1.f + __expf(2.f * x)); }
DI float ret_lg2(int hh) { const float x = ex2(-5.f - (float)hh); return -(x + x * x * (0.5f + x * (0.33333334f + x * 0.25f))) * 1.4426950408889634f; }

template <int CTRL> DI float dppf(float x) { return __builtin_bit_cast(float, __builtin_amdgcn_mov_dpp(__builtin_bit_cast(int, x), CTRL, 0xf, 0xf, true)); }
template <int CTRL> DI int dppi(int x) { return __builtin_amdgcn_mov_dpp(x, CTRL, 0xf, 0xf, true); }
DI float row16_sum(float x) { x += dppf<0xB1>(x); x += dppf<0x4E>(x); x += dppf<0x141>(x); x += dppf<0x128>(x); return x; }
DI int row16_sum(int x) { x += dppi<0xB1>(x); x += dppi<0x4E>(x); x += dppi<0x141>(x); x += dppi<0x128>(x); return x; }
DI float swap16_sum(float x) { auto s = __builtin_amdgcn_permlane16_swap(__float_as_uint(x), __float_as_uint(x), false, false); return __uint_as_float(s[0]) + __uint_as_float(s[1]); }
DI float swap32_sum(float x) { auto s = __builtin_amdgcn_permlane32_swap(__float_as_uint(x), __float_as_uint(x), false, false); return __uint_as_float(s[0]) + __uint_as_float(s[1]); }
DI float swap32_max(float x) { auto s = __builtin_amdgcn_permlane32_swap(__float_as_uint(x), __float_as_uint(x), false, false); return fmaxf(__uint_as_float(s[0]), __uint_as_float(s[1])); }
DI int swap16_sum(int x) { auto s = __builtin_amdgcn_permlane16_swap((unsigned)x, (unsigned)x, false, false); return (int)(s[0] + s[1]); }
DI int swap32_sum(int x) { auto s = __builtin_amdgcn_permlane32_swap((unsigned)x, (unsigned)x, false, false); return (int)(s[0] + s[1]); }
DI float wave_sum(float x) { return swap32_sum(swap16_sum(row16_sum(x))); }
DI unsigned umax_(unsigned a, unsigned b) { return a > b ? a : b; }
DI unsigned wave_umax(unsigned x) { x = umax_(x, (unsigned)dppi<0xB1>((int)x)); x = umax_(x, (unsigned)dppi<0x4E>((int)x)); x = umax_(x, (unsigned)dppi<0x141>((int)x)); x = umax_(x, (unsigned)dppi<0x128>((int)x));
    { auto s = __builtin_amdgcn_permlane16_swap(x, x, false, false); x = umax_(s[0], s[1]); } { auto s = __builtin_amdgcn_permlane32_swap(x, x, false, false); x = umax_(s[0], s[1]); } return x; }
DI int wave_sum(int x) { return swap32_sum(swap16_sum(row16_sum(x))); }
DI float half32_sum(float x) { return swap16_sum(row16_sum(x)); }
DI int crow(int r, int hi) { return (r & 3) + 8 * (r >> 2) + 4 * hi; }
#define MFMA32(a, b, c) __builtin_amdgcn_mfma_f32_32x32x16_bf16((a), (b), (c), 0, 0, 0)
#define MFMA16(a, b, c) __builtin_amdgcn_mfma_f32_16x16x32_bf16((a), (b), (c), 0, 0, 0)
#define LDS_WAIT() asm volatile("s_waitcnt lgkmcnt(0)" ::: "memory")
#define VM_WAIT() asm volatile("s_waitcnt vmcnt(0)" ::: "memory")
DI bf16x8 lds_frag(ldsp p) { return *(const LAS bf16x8*)p; }

namespace pg8 {
#define PG8_LAS __attribute__((address_space(3)))
typedef unsigned short bf16_t;
constexpr int BM = 256, BK = 64, HALF = 128, HTB = HALF * BK * 2, STAGE_BYTES = 8 * HTB, NXCD = 8, WGM = 8;
__host__ __device__ __forceinline__ int lds_byte(int r, int c) { const int st = (r >> 4) * 2 + (c >> 5), rr = r & 15, cc = c & 31, ob = rr * 64 + cc * 2; return st * 1024 + (ob ^ (((ob >> 9) & 1) << 5)); }
__host__ __device__ __forceinline__ void stage_rc(int b, int& R, int& C) { const int st = b / 1024, sb = b % 1024, swz = sb ^ (((sb >> 9) & 1) << 5); R = (st >> 1) * 16 + swz / 64; C = (st & 1) * 32 + (swz % 64) / 2; }
__host__ __device__ __forceinline__ int perm32(int rho) { const int n = rho >> 4, i = rho & 15; return 8 * (i >> 2) + 4 * n + (i & 3); }
struct Unit { int pm, pn; };
struct Gemm { const bf16_t* A; const bf16_t* Bt; int M, N, K; };
struct StaticOrder {
    int nM, nN, nwg, G, c;
    __host__ __device__ void init(int M_, int N_, int G_, int c_) { nM = M_ / BM; nN = N_ / BM; nwg = nM * nN; G = G_; c = c_; }
    __host__ __device__ bool next(int i, Unit& u) const {
        const long L = (long)i * G + c; if (L >= nwg) return false;
        int wgid = (int)L; { const int q = nwg / NXCD, r = nwg % NXCD, xcd = wgid % NXCD, off = wgid / NXCD; wgid = (xcd < r ? xcd * (q + 1) : r * (q + 1) + (xcd - r) * q) + off; }
        const int nig = WGM * nN, gid = wgid / nig, fm = gid * WGM, gsz = (nM - fm) < WGM ? (nM - fm) : WGM;
        u.pm = fm + ((wgid % nig) % gsz); u.pn = (wgid % nig) / gsz; return true;
    }
    __device__ __forceinline__ void a_ready(const Unit&) const {}
    __device__ __forceinline__ void done(const Unit&) const {}
};
DI float rstd_of(const float* ss16) {
    const f32x4* p = (const f32x4*)ss16; const f32x4 a = p[0], b = p[1], c = p[2], d = p[3];
    const float s = (((a[0] + a[1]) + (a[2] + a[3])) + ((b[0] + b[1]) + (b[2] + b[3]))) + (((c[0] + c[1]) + (c[2] + c[3])) + ((d[0] + d[1]) + (d[2] + d[3])));
    return __builtin_amdgcn_rsqf(s * (1.f / 1024.f) + RMS_EPS);
}
DI float rstd_q(const f32x4 a) { const float s = swap32_sum(swap16_sum((a[0] + a[1]) + (a[2] + a[3]))); return __builtin_amdgcn_rsqf(s * (1.f / 1024.f) + RMS_EPS); }
struct EpiSwiglu {
    static constexpr bool PERM = true, AFTER_DRAIN = false;
    bf16_t* O; const float* ss;
    __device__ __forceinline__ void operator()(const f32x4 (&acc)[2][2][4][2], const Unit& u, int wr, int wc, int fr, int fq) const {
        const int row0 = u.pm * BM + wr * 64 + fr, col0 = u.pn * 128 + wc * 32 + 8 * fq;
        f32x4 sq[2][4];
#pragma unroll
        for (int ai = 0; ai < 2; ++ai)
#pragma unroll
            for (int m = 0; m < 4; ++m) sq[ai][m] = *(const f32x4*)(ss + (size_t)(row0 + ai * HALF + m * 16) * 16 + 4 * fq);
#pragma unroll
        for (int ai = 0; ai < 2; ++ai)
#pragma unroll
            for (int m = 0; m < 4; ++m) { const int row = row0 + ai * HALF + m * 16; const float rs = rstd_q(sq[ai][m]);
                u32x4 w;
#pragma unroll
                for (int n = 0; n < 2; ++n) { const f32x4 g = acc[ai][0][m][n] * rs, up = acc[ai][1][m][n] * rs;
                    const float a0 = siluf_(g[0]) * up[0], a1 = siluf_(g[1]) * up[1], a2 = siluf_(g[2]) * up[2], a3 = siluf_(g[3]) * up[3];
                    w[2 * n] = pkh2(a0, a1); w[2 * n + 1] = pkh2(a2, a3); }
                *(u32x4*)(O + ((size_t)(u.pm * (DFF / BK) + (col0 >> 6)) * BM + (row & (BM - 1))) * BK + (col0 & 63)) = w; asm volatile("" ::: "memory"); }
    }
};
struct EpiNull {
    static constexpr bool PERM = true, AFTER_DRAIN = false; float* sink;
    __device__ __forceinline__ void operator()(const f32x4 (&acc)[2][2][4][2], const Unit& u, int wr, int wc, int fr, int fq) const {
        float s = 0.f;
#pragma unroll
        for (int ai = 0; ai < 2; ++ai)
#pragma unroll
            for (int bj = 0; bj < 2; ++bj)
#pragma unroll
                for (int m = 0; m < 4; ++m)
#pragma unroll
                    for (int n = 0; n < 2; ++n) s += acc[ai][bj][m][n][0] + acc[ai][bj][m][n][3];
        if (s == 1.2345e33f) sink[u.pm] = s;
    }
};
struct EpiResid {
    static constexpr bool PERM = true, AFTER_DRAIN = false;
    bf16_t* x16; float* ss_out; float alpha; int row_off;
    __device__ __forceinline__ void operator()(const f32x4 (&acc)[2][2][4][2], const Unit& u, int wr, int wc, int fr, int fq) const {
        const int row0 = row_off + u.pm * BM + wr * 64 + fr, col0 = u.pn * BM + wc * 32 + 8 * fq;
#pragma unroll
        for (int ai = 0; ai < 2; ++ai) {
            u32x4 xw[4][2];
#pragma unroll
            for (int m = 0; m < 4; ++m)
#pragma unroll
                for (int bj = 0; bj < 2; ++bj) xw[m][bj] = *(const u32x4*)(x16 + (size_t)(row0 + ai * HALF + m * 16) * D + col0 + bj * HALF);
#pragma unroll
            for (int m = 0; m < 4; ++m) { const int row = row0 + ai * HALF + m * 16; float sq = 0.f;
#pragma unroll
                for (int bj = 0; bj < 2; ++bj) { const u32x4 x4 = xw[m][bj]; u32x4 w;
#pragma unroll
                    for (int n = 0; n < 2; ++n) { const f32x4 xi = {hlo_f(x4[2 * n]), hhi_f(x4[2 * n]), hlo_f(x4[2 * n + 1]), hhi_f(x4[2 * n + 1])}; const f32x4 xo = xi + acc[ai][bj][m][n] * alpha;
                        w[2 * n] = pkh2(xo[0], xo[1]); w[2 * n + 1] = pkh2(xo[2], xo[3]);
                        sq += (xo[0] * xo[0] + xo[1] * xo[1]) + (xo[2] * xo[2] + xo[3] * xo[3]); }
                    *(u32x4*)(x16 + (size_t)row * D + col0 + bj * HALF) = w; }
                sq += __shfl_xor(sq, 16); sq += __shfl_xor(sq, 32);
                if (fq == 0) ss_out[(size_t)row * 16 + u.pn * 4 + wc] = sq; }
        }
    }
};
struct EpiProj {
    static constexpr bool PERM = true, AFTER_DRAIN = false;
    bf16_t* O; const float* ss;
    __device__ __forceinline__ void operator()(const f32x4 (&acc)[2][2][4][2], const Unit& u, int wr, int wc, int fr, int fq) const {
        const int row0 = u.pm * BM + wr * 64 + fr, col0 = u.pn * BM + wc * 32 + 8 * fq;
        f32x4 sq[2][4];
#pragma unroll
        for (int ai = 0; ai < 2; ++ai)
#pragma unroll
            for (int m = 0; m < 4; ++m) sq[ai][m] = *(const f32x4*)(ss + (size_t)(row0 + ai * HALF + m * 16) * 16 + 4 * fq);
#pragma unroll
        for (int ai = 0; ai < 2; ++ai)
#pragma unroll
            for (int m = 0; m < 4; ++m) { const int row = row0 + ai * HALF + m * 16; const float rs = rstd_q(sq[ai][m]);
#pragma unroll
                for (int bj = 0; bj < 2; ++bj) { const f32x4 v0 = acc[ai][bj][m][0] * rs, v1 = acc[ai][bj][m][1] * rs;
                    u32x4 w; w.x = pk2(v0[0], v0[1]); w.y = pk2(v0[2], v0[3]); w.z = pk2(v1[0], v1[1]); w.w = pk2(v1[2], v1[3]);
                    *(u32x4*)(O + (size_t)row * NPROJ + col0 + bj * HALF) = w; } asm volatile("" ::: "memory"); }
    }
};
template <int BR> struct EpiMerge {
    static constexpr bool PERM = false, AFTER_DRAIN = false;
    const bf16_t* proj; float* scratch; bf16_t* merged;
    __device__ __forceinline__ void operator()(const f32x4 (&acc)[2][2][4][2], const Unit& u, int wr, int wc, int fr, int fq) const {
        const int row0 = u.pm * BM + wr * 64 + fr, col0 = u.pn * BM + wc * 32 + 4 * fq;
#pragma unroll
        for (int ai = 0; ai < 2; ++ai)
#pragma unroll
            for (int m = 0; m < 4; ++m) { const int row = row0 + ai * HALF + m * 16;
#pragma unroll
                for (int bj = 0; bj < 2; ++bj)
#pragma unroll
                    for (int n = 0; n < 2; ++n) { const int c = col0 + bj * HALF + n * 16;
                        const u32x2 gw = *(const u32x2*)(proj + (size_t)row * NPROJ + C_GATE + BR * 1024 + c);
                        f32x4 g; g[0] = sigmoidf_(lo_f(gw.x)); g[1] = sigmoidf_(hi_f(gw.x)); g[2] = sigmoidf_(lo_f(gw.y)); g[3] = sigmoidf_(hi_f(gw.y));
                        f32x4 z = g * acc[ai][bj][m][n]; float* sp = scratch + (size_t)row * D + c;
                        if (BR == 0) { *(f32x4*)sp = z; }
                        else if (BR == 1) { z += *(const f32x4*)sp; *(f32x4*)sp = z; }
                        else { z += *(const f32x4*)sp; u32x2 w; w.x = pk2(z[0], z[1]); w.y = pk2(z[2], z[3]); *(u32x2*)(merged + (size_t)row * D + c) = w; } } }
    }
};

template <class Epi, class Sched, bool ALIGN_EPI = false, bool SP2 = false, bool ATILED = false, int PROBE = 0>
__device__ __forceinline__ void gemm_phase(PG8_LAS unsigned char* lds, const Gemm g, const Sched& S, const Epi& E, const int tid) {
    const int wid = __builtin_amdgcn_readfirstlane(tid >> 6), lane = tid & 63, wr = wid >> 2, wc = wid & 3, fr = lane & 15, fq = lane >> 4;
    const int K = g.K, nt = K / BK;
    unsigned voffA[2], voffB[2];
#pragma unroll
    for (int i = 0; i < 2; ++i) { int R, C; stage_rc(tid * 16 + i * 8192, R, C); const int Rb = Epi::PERM ? ((R & ~31) + perm32(R & 31)) : R;
        voffA[i] = (unsigned)(R * (ATILED ? BK : K) + C) * 2u; voffB[i] = (unsigned)(Rb * K + C) * 2u; }
    const size_t kstep = (size_t)(BK * 2);
    const size_t hstep = (size_t)HALF * K * 2;
    const size_t tstep = 2 * hstep;
    const size_t kstepA = ATILED ? (size_t)(BM * BK * 2) : kstep, hstepA = ATILED ? (size_t)(HALF * BK * 2) : hstep;
    const unsigned ldsw = (unsigned)wid * 1024u;
    const int aoff = lds_byte(wr * 64 + fr, fq * 8), boff = lds_byte(wc * 32 + fr, fq * 8);
#define PG8_SA(b, h) (((b) * 2 + (h)) * HTB)
#define PG8_SB(b, h) ((4 + (b) * 2 + (h)) * HTB)
#define PG8_STAGE(bufoff, gbase, voff) do { if (PROBE != 2 || !inloop) { _Pragma("unroll") for (int _i = 0; _i < 2; ++_i) \
        __builtin_amdgcn_global_load_lds((const unsigned*)((const char*)(gbase) + (voff)[_i]), (PG8_LAS unsigned*)(lds + (bufoff) + ldsw + _i * 8192), 16, 0, 0); } } while (0)
#define PG8_LDA(dst, b, h) do { if (PROBE != 3) { _Pragma("unroll") for (int m = 0; m < 4; ++m) _Pragma("unroll") for (int k = 0; k < 2; ++k) dst[m][k] = *(const PG8_LAS bf16x8*)(lds + PG8_SA(b, h) + aoff + m * 2048 + k * 1024); } } while (0)
#define PG8_LDB(dst, b, h) do { if (PROBE != 3) { _Pragma("unroll") for (int n = 0; n < 2; ++n) _Pragma("unroll") for (int k = 0; k < 2; ++k) dst[n][k] = *(const PG8_LAS bf16x8*)(lds + PG8_SB(b, h) + boff + n * 2048 + k * 1024); } } while (0)
#define PG8_MMA(ai, bj, At, Bt) do { if (PROBE != 1) { __builtin_amdgcn_s_setprio(1); _Pragma("unroll") for (int m = 0; m < 4; ++m) _Pragma("unroll") for (int n = 0; n < 2; ++n) _Pragma("unroll") for (int k = 0; k < 2; ++k) \
        acc[ai][bj][m][n] = GEMM_MFMA16(Bt[n][k], At[m][k], acc[ai][bj][m][n]); __builtin_amdgcn_s_setprio(0); } } while (0)
#define PG8_WAIT_V(n) asm volatile("s_waitcnt vmcnt(" #n ")" ::: "memory")
#define PG8_WAIT_L(n) asm volatile("s_waitcnt lgkmcnt(" #n ")" ::: "memory")
#define PG8_BAR __builtin_amdgcn_s_barrier()
#define PG8_SCHED __builtin_amdgcn_sched_barrier(0)
    Unit cur, nxt; int ui = 0;
    if (!S.next(0, cur)) return;
    f32x4 acc[2][2][4][2];
#pragma unroll
    for (int a = 0; a < 2; ++a)
#pragma unroll
        for (int b = 0; b < 2; ++b)
#pragma unroll
            for (int m = 0; m < 4; ++m)
#pragma unroll
                for (int n = 0; n < 2; ++n) acc[a][b][m][n] = (f32x4){0.f, 0.f, 0.f, 0.f};
    bf16x8 At[4][2], B0[2][2], B1[2][2];
    if constexpr (PROBE == 3) {
#pragma unroll
        for (int k = 0; k < 2; ++k) {
#pragma unroll
            for (int m = 0; m < 4; ++m) At[m][k] = (bf16x8){(short)(0x3c00 + tid), 0, 0, 0, 0, 0, 0, 0};
#pragma unroll
            for (int n = 0; n < 2; ++n) { B0[n][k] = (bf16x8){(short)(0x3c00 + tid), 0, 0, 0, 0, 0, 0, 0}; B1[n][k] = B0[n][k]; } } }
    bool inloop = false;
    const char* cA = (const char*)g.A + (size_t)cur.pm * tstep; const char* cB = (const char*)g.Bt + (size_t)cur.pn * tstep;
    S.a_ready(cur);
    if constexpr (SP2) {
        PG8_STAGE(PG8_SB(0, 0), cB, voffB); PG8_STAGE(PG8_SB(0, 1), cB + hstep, voffB); PG8_STAGE(PG8_SA(0, 0), cA, voffA); PG8_STAGE(PG8_SA(0, 1), cA + hstepA, voffA);
        if (wr == 1) PG8_BAR;
        PG8_WAIT_V(2); PG8_BAR;
        PG8_STAGE(PG8_SB(1, 0), cB + kstep, voffB); PG8_STAGE(PG8_SA(1, 0), cA + kstepA, voffA); PG8_STAGE(PG8_SB(1, 1), cB + hstep + kstep, voffB);
        PG8_WAIT_V(6); PG8_BAR;
    } else {
        PG8_STAGE(PG8_SB(0, 0), cB, voffB); PG8_STAGE(PG8_SA(0, 0), cA, voffA); PG8_STAGE(PG8_SB(0, 1), cB + hstep, voffB); PG8_STAGE(PG8_SA(0, 1), cA + hstepA, voffA);
        if (wr == 1) PG8_BAR;
        PG8_WAIT_V(4); PG8_BAR;
        PG8_STAGE(PG8_SB(1, 0), cB + kstep, voffB); PG8_STAGE(PG8_SA(1, 0), cA + kstepA, voffA); PG8_STAGE(PG8_SB(1, 1), cB + hstep + kstep, voffB);
        PG8_WAIT_V(6); PG8_BAR;
    }
    inloop = true;
    for (;;) {
        const bool has_next = S.next(ui + 1, nxt);
        const char* nA = has_next ? (const char*)g.A + (size_t)nxt.pm * tstep : cA; const char* nB = has_next ? (const char*)g.Bt + (size_t)nxt.pn * tstep : cB;
        for (int t = 0; t < nt; t += 2) {
            const bool last = (t == nt - 2);
            const char* a1 = cA + (size_t)(t + 1) * kstepA;
            const char* a2 = last ? nA : cA + (size_t)(t + 2) * kstepA; const char* b2 = last ? nB : cB + (size_t)(t + 2) * kstep;
            const char* a3 = a2 + kstepA; const char* b3 = b2 + kstep;
            if (last && has_next) S.a_ready(nxt);
            if constexpr (SP2) {
            PG8_LDB(B0, 0, 0); PG8_LDB(B1, 0, 1); PG8_SCHED; PG8_LDA(At, 0, 0); PG8_STAGE(PG8_SA(1, 1), a1 + hstepA, voffA);
            PG8_WAIT_V(8); PG8_WAIT_L(0); PG8_BAR; PG8_MMA(0, 0, At, B0); PG8_MMA(0, 1, At, B1); PG8_BAR; PG8_SCHED;
            PG8_LDA(At, 0, 1); PG8_STAGE(PG8_SB(0, 0), b2, voffB); PG8_STAGE(PG8_SB(0, 1), b2 + hstep, voffB); PG8_STAGE(PG8_SA(0, 0), a2, voffA);
            PG8_WAIT_V(8); PG8_WAIT_L(0); PG8_BAR; PG8_MMA(1, 0, At, B0); PG8_MMA(1, 1, At, B1); PG8_BAR; PG8_SCHED;
            PG8_LDB(B0, 1, 0); PG8_LDB(B1, 1, 1); PG8_SCHED; PG8_LDA(At, 1, 0); PG8_STAGE(PG8_SA(0, 1), a2 + hstepA, voffA);
            PG8_WAIT_V(8); PG8_WAIT_L(0); PG8_BAR; PG8_MMA(0, 0, At, B0); PG8_MMA(0, 1, At, B1); PG8_BAR; PG8_SCHED;
            PG8_LDA(At, 1, 1); PG8_STAGE(PG8_SB(1, 0), b3, voffB); PG8_STAGE(PG8_SB(1, 1), b3 + hstep, voffB); PG8_STAGE(PG8_SA(1, 0), a3, voffA);
            PG8_WAIT_V(8); PG8_WAIT_L(0); PG8_BAR; PG8_MMA(1, 0, At, B0); PG8_MMA(1, 1, At, B1); PG8_BAR; PG8_SCHED;
            } else {
            PG8_LDB(B0, 0, 0); PG8_SCHED; PG8_LDA(At, 0, 0); PG8_STAGE(PG8_SA(1, 1), a1 + hstepA, voffA);
            PG8_WAIT_L(8); PG8_BAR; PG8_WAIT_L(0); PG8_MMA(0, 0, At, B0); PG8_BAR; PG8_SCHED;
            PG8_LDB(B1, 0, 1); PG8_STAGE(PG8_SB(0, 0), b2, voffB);
            PG8_BAR; PG8_WAIT_L(0); PG8_MMA(0, 1, At, B1); PG8_BAR;
            PG8_LDA(At, 0, 1); PG8_STAGE(PG8_SA(0, 0), a2, voffA);
            PG8_BAR; PG8_WAIT_L(0); PG8_MMA(1, 0, At, B0); PG8_BAR; PG8_SCHED;
            PG8_STAGE(PG8_SB(0, 1), b2 + hstep, voffB);
            PG8_WAIT_V(6); PG8_BAR; PG8_MMA(1, 1, At, B1); PG8_BAR;
            PG8_LDB(B0, 1, 0); PG8_SCHED; PG8_LDA(At, 1, 0); PG8_STAGE(PG8_SA(0, 1), a2 + hstepA, voffA);
            PG8_WAIT_L(8); PG8_BAR; PG8_WAIT_L(0); PG8_MMA(0, 0, At, B0); PG8_BAR; PG8_SCHED;
            PG8_LDB(B1, 1, 1); PG8_STAGE(PG8_SB(1, 0), b3, voffB);
            PG8_BAR; PG8_WAIT_L(0); PG8_MMA(0, 1, At, B1); PG8_BAR;
            PG8_LDA(At, 1, 1); PG8_STAGE(PG8_SA(1, 0), a3, voffA);
            PG8_BAR; PG8_WAIT_L(0); PG8_MMA(1, 0, At, B0); PG8_BAR; PG8_SCHED;
            PG8_STAGE(PG8_SB(1, 1), b3 + hstep, voffB);
            PG8_WAIT_V(6); PG8_BAR; PG8_MMA(1, 1, At, B1); PG8_BAR;
            }
        }
        if constexpr (ALIGN_EPI) { if (wr == 0) PG8_BAR; }
        if constexpr (!Epi::AFTER_DRAIN) { E(acc, cur, wr, wc, fr, fq); S.done(cur); }
        if (!has_next) break;
#pragma unroll
        for (int a = 0; a < 2; ++a)
#pragma unroll
            for (int b = 0; b < 2; ++b)
#pragma unroll
                for (int m = 0; m < 4; ++m)
#pragma unroll
                    for (int n = 0; n < 2; ++n) acc[a][b][m][n] = (f32x4){0.f, 0.f, 0.f, 0.f};
        cur = nxt; cA = nA; cB = nB; ++ui;
        if constexpr (ALIGN_EPI) { if (wr == 1) PG8_BAR; }
    }
    PG8_WAIT_V(0);
    if constexpr (!ALIGN_EPI) { if (wr == 0) PG8_BAR; }
    PG8_BAR;
#undef PG8_SA
#undef PG8_SB
#undef PG8_STAGE
#undef PG8_LDA
#undef PG8_LDB
#undef PG8_MMA
#undef PG8_WAIT_V
#undef PG8_WAIT_L
#undef PG8_BAR
#undef PG8_SCHED
}
struct UnitH { int pm, pn, br; };
template <class Epi, class Sched, int LD>
__device__ __forceinline__ void gemm_nhalf_phase(PG8_LAS unsigned char* lds, const Sched& S, Epi& E, const int tid) {
    const int wid = __builtin_amdgcn_readfirstlane(tid >> 6), lane = tid & 63, wr = wid >> 2, wc = wid & 3, fr = lane & 15, fq = lane >> 4;
    unsigned voff[2], voffB[2];
#pragma unroll
    for (int i = 0; i < 2; ++i) { int R, C; stage_rc(tid * 16 + i * 8192, R, C); voff[i] = (unsigned)(R * LD + C) * 2u; voffB[i] = (unsigned)(((R & ~31) + perm32(R & 31)) * LD + C) * 2u; }
    const size_t kstep = (size_t)(BK * 2);
    const size_t hstep = (size_t)HALF * LD * 2;
    const unsigned ldsw = (unsigned)wid * 1024u;
    const int aoff = lds_byte(wr * 64 + fr, fq * 8), boff = lds_byte(wc * 32 + fr, fq * 8);
#define NH_BUF(b, h) (((b) * 3 + (h)) * HTB)
#define NH_STAGE(bufoff, gbase, vo) do { _Pragma("unroll") for (int _i = 0; _i < 2; ++_i) \
        __builtin_amdgcn_global_load_lds((const unsigned*)((const char*)(gbase) + (vo)[_i]), (PG8_LAS unsigned*)(lds + (bufoff) + ldsw + _i * 8192), 16, 0, 0); } while (0)
#define NH_STAGE3(b, pa, pb) do { NH_STAGE(NH_BUF(b, 2), pb, voffB); NH_STAGE(NH_BUF(b, 0), pa, voff); NH_STAGE(NH_BUF(b, 1), (pa) + hstep, voff); } while (0)
#define NH_BAR __builtin_amdgcn_s_barrier()
    UnitH cur, nxt;
    if (!S.next(0, cur)) return;
    f32x4 acc[2][4][2];
#pragma unroll
    for (int a = 0; a < 2; ++a)
#pragma unroll
        for (int m = 0; m < 4; ++m)
#pragma unroll
            for (int n = 0; n < 2; ++n) acc[a][m][n] = (f32x4){0.f, 0.f, 0.f, 0.f};
    const char* cA; const char* cB; int nt; S.bases(cur, cA, cB, nt);
    E.prefetch(cur, wr, wc, fr, fq);
    int pi = 0, pt = 0; UnitH pu = cur; const char* pA = cA; const char* pB = cB; int pnt = nt; bool pvalid = true;
    auto padvance = [&]() { if (!pvalid) return; if (++pt == pnt) { UnitH nu; if (S.next(pi + 1, nu)) { ++pi; pu = nu; S.bases(pu, pA, pB, pnt); pt = 0; } else pvalid = false; } };
    NH_STAGE3(0, pA, pB); padvance();
    if (pvalid) { NH_STAGE3(1, pA + (size_t)pt * kstep, pB + (size_t)pt * kstep); } padvance();
    asm volatile("s_waitcnt vmcnt(6)" ::: "memory");
    NH_BAR;
    if (wr == 1) NH_BAR;
    int ui = 0, bufc = 0;
    for (;;) {
        const bool has_next = S.next(ui + 1, nxt);
        for (int t = 0; t < nt; ++t) {
            bf16x8 At[2][4][2], B0[2][2];
#pragma unroll
            for (int n = 0; n < 2; ++n)
#pragma unroll
                for (int k = 0; k < 2; ++k) B0[n][k] = *(const PG8_LAS bf16x8*)(lds + NH_BUF(bufc, 2) + boff + n * 2048 + k * 1024);
#pragma unroll
            for (int a = 0; a < 2; ++a)
#pragma unroll
                for (int m = 0; m < 4; ++m)
#pragma unroll
                    for (int k = 0; k < 2; ++k) At[a][m][k] = *(const PG8_LAS bf16x8*)(lds + NH_BUF(bufc, a) + aoff + m * 2048 + k * 1024);
            const int bufn = bufc >= 1 ? bufc - 1 : 2;
            if (pvalid) { NH_STAGE3(bufn, pA + (size_t)pt * kstep, pB + (size_t)pt * kstep);
                if (t == 0 && ui > 0) asm volatile("s_waitcnt vmcnt(14)" ::: "memory");
                else asm volatile("s_waitcnt vmcnt(6)" ::: "memory"); }
            else asm volatile("s_waitcnt vmcnt(0)" ::: "memory");
            padvance();
            asm volatile("s_waitcnt lgkmcnt(0)" ::: "memory");
            NH_BAR;
            __builtin_amdgcn_s_setprio(1);
#pragma unroll
            for (int a = 0; a < 2; ++a)
#pragma unroll
                for (int m = 0; m < 4; ++m)
#pragma unroll
                    for (int n = 0; n < 2; ++n)
#pragma unroll
                        for (int k = 0; k < 2; ++k) acc[a][m][n] = GEMM_MFMA16(B0[n][k], At[a][m][k], acc[a][m][n]);
            __builtin_amdgcn_s_setprio(0);
            NH_BAR;
            bufc = bufc == 2 ? 0 : bufc + 1;
        }
        if constexpr (!Epi::AFTER_DRAIN) E(acc, cur, wr, wc, fr, fq);
        if (!has_next) break;
#pragma unroll
        for (int a = 0; a < 2; ++a)
#pragma unroll
            for (int m = 0; m < 4; ++m)
#pragma unroll
                for (int n = 0; n < 2; ++n) acc[a][m][n] = (f32x4){0.f, 0.f, 0.f, 0.f};
        cur = nxt; S.bases(cur, cA, cB, nt); ++ui;
        E.prefetch(cur, wr, wc, fr, fq);
    }
    asm volatile("s_waitcnt vmcnt(0)" ::: "memory");
    if (wr == 0) NH_BAR;
    NH_BAR;
    if constexpr (Epi::AFTER_DRAIN) E.fused(acc, cur, wr, wc, fr, fq, lds, tid);
#undef NH_BUF
#undef NH_STAGE
#undef NH_STAGE3
#undef NH_BAR
}
struct MergeSched {
    const char *Aret, *Adr, *Bret, *Bdr; int ntiles, c, nN;
    __device__ __forceinline__ bool next(int i, UnitH& u) const { if (c >= ntiles || i >= 3) return false; const int x = c & 7, r = c >> 3, ppx = ntiles / nN / 8; u.pm = x * ppx + r / nN; u.pn = r % nN; u.br = i; return true; }
    __device__ __forceinline__ void bases(const UnitH& u, const char*& A, const char*& B, int& nt) const {
        const size_t ao = (size_t)u.pm * 256 * 1024 * 2, bo = (size_t)u.pn * 128 * 1024 * 2;
        if (u.br == 0) { A = Aret + ao; B = Bret + bo; nt = 16; } else { A = Adr + ao + (u.br == 2 ? 1024 : 0); B = Bdr + bo + (u.br == 2 ? 1024 : 0); nt = 8; }
    }
};
struct EpiMerge3 {
    static constexpr bool AFTER_DRAIN = false;
    const bf16_t* proj; bf16_t* merged; u32x2 msh[2][4][2]; u32x4 gw[2][4];
    __device__ __forceinline__ void prefetch(const UnitH& u, int wr, int wc, int fr, int fq) {
        const int row0 = u.pm * BM + wr * 64 + fr, col0 = u.pn * 128 + wc * 32 + 8 * fq;
#pragma unroll
        for (int ai = 0; ai < 2; ++ai)
#pragma unroll
            for (int m = 0; m < 4; ++m) gw[ai][m] = *(const u32x4*)(proj + (size_t)(row0 + ai * HALF + m * 16) * NPROJ + C_GATE + u.br * 1024 + col0);
    }
    __device__ __forceinline__ void operator()(const f32x4 (&acc)[2][4][2], const UnitH& u, int wr, int wc, int fr, int fq) {
        const int row0 = u.pm * BM + wr * 64 + fr, col0 = u.pn * 128 + wc * 32 + 8 * fq;
#pragma unroll
        for (int ai = 0; ai < 2; ++ai)
#pragma unroll
            for (int m = 0; m < 4; ++m) { const int row = row0 + ai * HALF + m * 16; const u32x4 g4 = gw[ai][m]; u32x4 w;
#pragma unroll
                for (int n = 0; n < 2; ++n) {
                    f32x4 g; g[0] = sigmoidf_(lo_f(g4[2 * n])); g[1] = sigmoidf_(hi_f(g4[2 * n])); g[2] = sigmoidf_(lo_f(g4[2 * n + 1])); g[3] = sigmoidf_(hi_f(g4[2 * n + 1]));
                    f32x4 t = g * acc[ai][m][n];
                    if (u.br != 0) { const u32x2 o = msh[ai][m][n]; t += (f32x4){hlo_f(o.x), hhi_f(o.x), hlo_f(o.y), hhi_f(o.y)}; }
                    u32x2 pk; pk.x = pkh2(t[0], t[1]); pk.y = pkh2(t[2], t[3]); msh[ai][m][n] = pk; w[2 * n] = pk.x; w[2 * n + 1] = pk.y; }
                if (u.br == 2) *(u32x4*)(merged + (size_t)row * D + col0) = w; }
    }
};
struct OneSchedH {
    const char *A, *B; int ntiles, c, nN, nt;
    __device__ __forceinline__ bool next(int i, UnitH& u) const { if (c >= ntiles || i >= 1) return false; const int x = c & 7, r = c >> 3, ppx = ntiles / nN / 8; u.pm = x * ppx + r / nN; u.pn = r % nN; u.br = 0; return true; }
    __device__ __forceinline__ void bases(const UnitH& u, const char*& a, const char*& b, int& nt_) const { a = A + (size_t)u.pm * 256 * 1024 * 2; b = B + (size_t)u.pn * 128 * 1024 * 2; nt_ = nt; }
};
struct EpiResidH {
    static constexpr bool AFTER_DRAIN = true;
    bf16_t* x16; float* ss_out; float alpha; int row_off;
    __device__ __forceinline__ void fused(const f32x4 (&acc)[2][4][2], const UnitH& u, int wr, int wc, int fr, int fq, PG8_LAS unsigned char* lds, int tid) const {
        PG8_LAS float* tab = (PG8_LAS float*)lds;
        const int col0 = u.pn * 128 + wc * 32 + 8 * fq;
        u32x4 xw[2][4];
#pragma unroll
        for (int ai = 0; ai < 2; ++ai)
#pragma unroll
            for (int m = 0; m < 4; ++m) xw[ai][m] = *(const u32x4*)(x16 + (size_t)(row_off + u.pm * BM + ai * HALF + wr * 64 + m * 16 + fr) * D + col0);
#pragma unroll
        for (int ai = 0; ai < 2; ++ai)
#pragma unroll
            for (int m = 0; m < 4; ++m) { const int rl = ai * HALF + wr * 64 + m * 16 + fr; const int row = row_off + u.pm * BM + rl; float sq = 0.f; const u32x4 x4 = xw[ai][m]; u32x4 w;
#pragma unroll
                for (int n = 0; n < 2; ++n) { const f32x4 xi = {hlo_f(x4[2 * n]), hhi_f(x4[2 * n]), hlo_f(x4[2 * n + 1]), hhi_f(x4[2 * n + 1])}; const f32x4 xo = xi + acc[ai][m][n] * alpha;
                    w[2 * n] = pkh2(xo[0], xo[1]); w[2 * n + 1] = pkh2(xo[2], xo[3]);
                    sq += (xo[0] * xo[0] + xo[1] * xo[1]) + (xo[2] * xo[2] + xo[3] * xo[3]); }
                *(u32x4*)(x16 + (size_t)row * D + col0) = w;
                sq += __shfl_xor(sq, 16); sq += __shfl_xor(sq, 32);
                if (fq == 0) tab[rl * 4 + wc] = sq; }
        __syncthreads();
        { const int t = tid; const int rl = t >> 1, hf = t & 1;
          ss_out[(size_t)(row_off + u.pm * BM + rl) * 16 + u.pn * 2 + hf] = tab[rl * 4 + 2 * hf] + tab[rl * 4 + 2 * hf + 1]; }
    }
};
}
#ifndef PG8_SP2
#define PG8_SP2 true
#endif
#ifndef PG8_ALIGN
#define PG8_ALIGN true
#endif

constexpr size_t MiB = 1u << 20;
constexpr size_t WS_CTL = 0, CTL_ZERO_BYTES = 1 * MiB;
constexpr size_t WS_TAB = 1 * MiB;
constexpr size_t TAB_RCOS = 0, TAB_RSIN = (size_t)T * 32 * 4, TAB_PCOS = 2 * (size_t)T * 32 * 4, TAB_PSIN = TAB_PCOS + (size_t)T * 8 * 4;
constexpr size_t WS_SS = 2 * MiB, SS_BYTES = (size_t)M * 16 * 4;
constexpr size_t WS_XB = 16 * MiB;
constexpr size_t WS_W = 80 * MiB, W_LAYER_BYTES = 58 * MiB;
constexpr size_t WO_FFA_IN = 0, WO_FFA_OUT = WO_FFA_IN + (size_t)2 * DFF * D, WO_WIN = WO_FFA_OUT + (size_t)D * DFF, WO_PRET = WO_WIN + (size_t)NPROJ * D,
                 WO_PDR = WO_PRET + (size_t)D * 1024, WO_WOUT = WO_PDR + (size_t)D * 1024, WO_FFB_IN = WO_WOUT + (size_t)D * D,
                 WO_FFB_OUT = WO_FFB_IN + (size_t)2 * DFF * D, WO_W2T = WO_FFB_OUT + (size_t)D * DFF, WO_A2T = WO_W2T + 512 * 64, WO_G2T = WO_A2T + 512 * 64, WO_END = WO_G2T + 512 * 128;
static_assert(WO_END * 2 <= W_LAYER_BYTES, "weights fit");
constexpr size_t WS_GRP = 196 * MiB;
constexpr size_t WS_ACT = WS_GRP;
constexpr size_t WS_PROJ = WS_GRP;
constexpr size_t WS_PR = WS_GRP + 144 * MiB, WS_PK = WS_PR + 8 * MiB, WS_PV = WS_PK + 8 * MiB, WS_PKK = WS_PV + 8 * MiB, WS_PB = WS_PKK + 8 * MiB;
constexpr size_t WS_PW = WS_PB + 8 * MiB;
constexpr size_t WS_PG = WS_PW + 16 * MiB;
constexpr size_t WS_PC = WS_PG + 8 * MiB;
constexpr size_t WS_RQR = WS_PR, WS_RKR = WS_PK, WS_RVT = WS_PW;
constexpr size_t WS_RS = WS_PKK;
constexpr size_t WS_SCR = WS_PR;
constexpr size_t WS_YRET = WS_PC + 1 * MiB, WS_YDR = WS_YRET + 16 * MiB;
constexpr size_t WS_MERGED = WS_YDR + 16 * MiB;
constexpr size_t WS_MASK = WS_MERGED + 16 * MiB;
constexpr int NCHAIN = BG * 8, NRCH = T / 64;
constexpr size_t WS_RG = WS_MASK + 2 * MiB;
constexpr size_t WS_RRP = WS_RG + 8 * MiB, WS_RH = WS_RRP + 8 * MiB, WS_RY0 = WS_RH + 8 * MiB, WS_RSC = WS_RY0 + 16 * MiB;
constexpr size_t WS_RU = WS_RSC + 8 * MiB;
constexpr size_t WS_VT = WS_RU + 8 * MiB;
constexpr size_t WS_END = WS_VT + 1 * MiB;
static_assert((size_t)NCHAIN * NRCH * 64 * 64 * 2 <= 8 * MiB, "rwkv item buffers");
static_assert(WS_END <= 512 * MiB && WS_ACT + (size_t)M * DFF * 2 <= 512 * MiB, "workspace map");
constexpr int CW_BAR = 4096, CW_QUEUE = 16384;

constexpr int LDS_BYTES = 163840, MISC_OFF = LDS_BYTES - 256;

#define XB_TMO      128
#define XB_XCNT(j)  (256  + 64 * (j))
#define XB_XSUB(j)  (1280 + 64 * (j))
#define XB_XGEN(j)  (2304 + 64 * (j))
#define XB_TOP      3328
#define XB_TOPGEN   3392
#define XCD_BAR_WORDS 3456
#define XB_SPIN_CAP (1u << 18)
__device__ __forceinline__ unsigned xb_ld(unsigned* p)              { return __hip_atomic_load(p, __ATOMIC_RELAXED, __HIP_MEMORY_SCOPE_AGENT); }
__device__ __forceinline__ unsigned xb_add(unsigned* p, unsigned v) { return __hip_atomic_fetch_add(p, v, __ATOMIC_RELAXED, __HIP_MEMORY_SCOPE_AGENT); }
__device__ __forceinline__ unsigned xb_xcc_id() { return (unsigned)__builtin_amdgcn_s_getreg((3 << 11) | 20) & 0xFu; }
#define XB_SPIN(cond, bar) do { unsigned _sp = 0; while (cond) { __builtin_amdgcn_s_sleep(1); \
    if ((++_sp & 255u) == 0u) { if (xb_ld(&(bar)[XB_TMO])) break; if (_sp > XB_SPIN_CAP) { atomicAdd(&(bar)[XB_TMO], 1u); break; } } } } while (0)
struct XcdBarrier { unsigned* bar; unsigned x; volatile LAS unsigned* st; };
__device__ __forceinline__ XcdBarrier xcd_barrier_post(unsigned* bar, volatile LAS unsigned* st) {
    XcdBarrier b; b.bar = bar; b.x = xb_xcc_id(); b.st = st;
    if (threadIdx.x == 0) (void)xb_add(&bar[XB_XCNT(b.x)], 1u);
    return b;
}
__device__ __forceinline__ void xcd_barrier_complete(unsigned* bar, unsigned x, unsigned& nloc, unsigned& nx) {
    const unsigned G = gridDim.x * gridDim.y * gridDim.z;
    unsigned sum, cnt, mine, sp = 0u;
    for (;;) {
        sum = 0u; cnt = 0u; mine = 0u;
#pragma unroll
        for (unsigned j = 0; j < 16; ++j) { const unsigned c = xb_ld(&bar[XB_XCNT(j)]); sum += c; cnt += (c > 0u) ? 1u : 0u; mine = (j == x) ? c : mine; }
        if (sum == G) break;
        __builtin_amdgcn_s_sleep(1);
        if ((++sp & 255u) == 0u) { if (xb_ld(&bar[XB_TMO])) break; if (sp > XB_SPIN_CAP) { atomicAdd(&bar[XB_TMO], 1u); break; } }
    }
    nloc = mine > 0u ? mine : 1u; nx = cnt > 0u ? cnt : 1u;
}
__device__ __forceinline__ void xcd_barrier(const XcdBarrier& b) {
    asm volatile("s_waitcnt vmcnt(0)" ::: "memory");
    __syncthreads();
    if (threadIdx.x == 0) {
        unsigned* bar = b.bar;
        __builtin_amdgcn_s_waitcnt(0);
        unsigned nloc = b.st[0], nx = b.st[1];
        if (nloc == 0u) { xcd_barrier_complete(bar, b.x, nloc, nx); b.st[0] = nloc; b.st[1] = nx; }
        const unsigned old = xb_add(&bar[XB_XSUB(b.x)], 1u);
        const unsigned gen = old / nloc;
        if (old + 1u == (gen + 1u) * nloc) {
            __builtin_amdgcn_fence(__ATOMIC_RELEASE, "agent");
            asm volatile("s_waitcnt vmcnt(0)" ::: "memory");
            const unsigned og = xb_add(&bar[XB_TOP], 1u);
            const unsigned tg = og / nx;
            if (og + 1u == (tg + 1u) * nx) xb_add(&bar[XB_TOPGEN], 1u);
            else XB_SPIN(xb_ld(&bar[XB_TOPGEN]) == tg, bar);
            __builtin_amdgcn_fence(__ATOMIC_ACQUIRE, "agent");
            xb_add(&bar[XB_XGEN(b.x)], 1u);
            asm volatile("s_waitcnt vmcnt(0)" ::: "memory");
        } else {
            XB_SPIN(xb_ld(&bar[XB_XGEN(b.x)]) == gen, bar);
            __builtin_amdgcn_fence(__ATOMIC_ACQUIRE, "agent");
            asm volatile("s_waitcnt vmcnt(0)" ::: "memory");
        }
    }
    __syncthreads();
}

struct Args { const float* in[25]; float* out; unsigned char* ws; float inv_ret[32]; float inv_rot[8]; };
enum { I_X = 0, I_NORM_FFA, I_FFA_WIN, I_FFA_WOUT, I_NORM_MIX, I_WIN, I_MU, I_W0, I_W2, I_A0, I_A2, I_G2, I_KK, I_KA, I_RK, I_LNW, I_LNB, I_PRET, I_PDSA, I_PRWKV, I_WOUT,
       I_NORM_FFB, I_FFB_WIN, I_FFB_WOUT, I_NORM_FINAL };

DI int src_col(int kind, int nd) {
    if (kind == 0) return nd;
    if (kind == 1) { const int pn = nd >> 8, j = nd & 255; return j < 128 ? 128 * pn + j : DFF + 128 * pn + (j - 128); }
    if (nd < 4036) return nd; if (nd < 4096) return -1; if (nd < 8960) return nd - 60; return -1;
}
DI void cvt_item(const float* W, int K, int Nsrc, bf16* WT, int ldw, int kind, const float* gain, LAS float* scr, int item, int nblk, int lane, bool f16) {
    const int kb = item / nblk, nb = item % nblk, k0 = 64 * kb, n0 = 32 * nb;
    const int sc = src_col(kind, n0 + (lane & 31));
    float vv[32];
#pragma unroll
    for (int i = 0; i < 32; ++i) { const int kk = 2 * i + (lane >> 5); vv[i] = (sc >= 0) ? W[(size_t)(k0 + kk) * Nsrc + sc] : 0.f; }
#pragma unroll
    for (int i = 0; i < 32; ++i) { const int kk = 2 * i + (lane >> 5); float v = vv[i]; if (gain) v *= gain[k0 + kk]; scr[kk * 33 + (lane & 31)] = v; }
    LDS_WAIT();
    const int c = lane & 7;
#pragma unroll
    for (int j = 0; j < 4; ++j) { const int n = (lane >> 3) + 8 * j; const LAS float* s = scr + (8 * c) * 33 + n;
        u32x4 o;
        if (f16) { o.x = pkh2(s[0 * 33], s[1 * 33]); o.y = pkh2(s[2 * 33], s[3 * 33]); o.z = pkh2(s[4 * 33], s[5 * 33]); o.w = pkh2(s[6 * 33], s[7 * 33]); }
        else { o.x = pk2(s[0 * 33], s[1 * 33]); o.y = pk2(s[2 * 33], s[3 * 33]); o.z = pk2(s[4 * 33], s[5 * 33]); o.w = pk2(s[6 * 33], s[7 * 33]); }
        *(u32x4*)(WT + (size_t)(n0 + n) * ldw + k0 + 8 * c) = o; }
    LDS_WAIT();
}
DI void sincos_d(float angf, float& c, float& s) {
    const double x = (double)angf; const double n = __builtin_rint(x * 0.15915494309189535); double r = __builtin_fma(-n, 6.283185307179586, x); r = __builtin_fma(-n, 2.4492935982947064e-16, r);
    const double r2 = r * r; double cs = 1.0, sn = r, tc = 1.0, tsn = r;
#pragma unroll 1
    for (int k = 1; k <= 14; ++k) { tc = -tc * r2 / (double)((2 * k - 1) * (2 * k)); tsn = -tsn * r2 / (double)((2 * k) * (2 * k + 1)); cs += tc; sn += tsn; }
    c = (float)cs; s = (float)sn;
}

struct Ctx { ldsp lds; int tid, lane, wave, G, blk; };
DI Ctx fresh(const Ctx& C0) { Ctx C = C0; asm volatile("" : "+v"(C.tid)); C.lane = C.tid & 63; C.wave = __builtin_amdgcn_readfirstlane(C.tid >> 6); asm volatile("" : "+s"(C.blk)); asm volatile("" : "+s"(C.G)); return C; }
typedef const __attribute__((address_space(4))) Args* kargp;
DI kargp kargs() { kargp p = (kargp)__builtin_amdgcn_kernarg_segment_ptr(); asm volatile("" : "+s"(p)); return p; }

DI void p0_prologue(const Ctx& C) {
    const kargp ap = kargs(); unsigned char* const ws = ap->ws;
    LAS float* scr = (LAS float*)(C.lds + C.wave * 16384);
    const int gw = C.blk * 8 + C.wave, NGW = C.G * 8;
    constexpr int I_FFIN = (D / 64) * (2 * DFF / 32), I_FFOUT = (DFF / 64) * (D / 32), I_WINP = (D / 64) * (NPROJ / 32), I_PR = (1024 / 64) * (D / 32), I_PD = (512 / 64) * (D / 32),
                  I_WO = (D / 64) * (D / 32), I_L64 = 1 * (512 / 32), I_L128 = 2 * (512 / 32);
    constexpr int PER_LAYER = 2 * I_FFIN + 2 * I_FFOUT + I_WINP + I_PR + 2 * I_PD + I_WO + 2 * I_L64 + I_L128;
    for (int it = gw; it < DEPTH * PER_LAYER; it += NGW) {
        const int l = it / PER_LAYER; int r = it - l * PER_LAYER;
        bf16* wl = (bf16*)(ws + WS_W + (size_t)l * W_LAYER_BYTES);
        const float* src; bf16* dst; int K, Nsrc, Ndst, kind = 0, ldw = 0; const float* gain = nullptr; bool f16 = true;
        if (r < I_FFIN) { src = ap->in[I_FFA_WIN] + (size_t)l * D * 2 * DFF; dst = wl + WO_FFA_IN; K = D; Nsrc = 2 * DFF; Ndst = 2 * DFF; kind = 1; gain = ap->in[I_NORM_FFA] + l * D; }
        else if ((r -= I_FFIN) < I_FFOUT) { src = ap->in[I_FFA_WOUT] + (size_t)l * DFF * D; dst = wl + WO_FFA_OUT; K = DFF; Nsrc = D; Ndst = D; }
        else if ((r -= I_FFOUT) < I_WINP) { src = ap->in[I_WIN] + (size_t)l * D * 8900; dst = wl + WO_WIN; K = D; Nsrc = 8900; Ndst = NPROJ; kind = 2; gain = ap->in[I_NORM_MIX] + l * D; }
        else if ((r -= I_WINP) < I_PR) { src = ap->in[I_PRET] + (size_t)l * 1024 * D; dst = wl + WO_PRET; K = 1024; Nsrc = D; Ndst = D; }
        else if ((r -= I_PR) < I_PD) { src = ap->in[I_PDSA] + (size_t)l * 512 * D; dst = wl + WO_PDR; K = 512; Nsrc = D; Ndst = D; ldw = 1024; }
        else if ((r -= I_PD) < I_PD) { src = ap->in[I_PRWKV] + (size_t)l * 512 * D; dst = wl + WO_PDR + 512; K = 512; Nsrc = D; Ndst = D; ldw = 1024; }
        else if ((r -= I_PD) < I_WO) { src = ap->in[I_WOUT] + (size_t)l * D * D; dst = wl + WO_WOUT; K = D; Nsrc = D; Ndst = D; }
        else if ((r -= I_WO) < I_FFIN) { src = ap->in[I_FFB_WIN] + (size_t)l * D * 2 * DFF; dst = wl + WO_FFB_IN; K = D; Nsrc = 2 * DFF; Ndst = 2 * DFF; kind = 1; gain = ap->in[I_NORM_FFB] + l * D; }
        else if ((r -= I_FFIN) < I_FFOUT) { src = ap->in[I_FFB_WOUT] + (size_t)l * DFF * D; dst = wl + WO_FFB_OUT; K = DFF; Nsrc = D; Ndst = D; }
        else if ((r -= I_FFOUT) < I_L64) { src = ap->in[I_W2] + (size_t)l * 64 * 512; dst = wl + WO_W2T; K = 64; Nsrc = 512; Ndst = 512; f16 = false; }
        else if ((r -= I_L64) < I_L64) { src = ap->in[I_A2] + (size_t)l * 64 * 512; dst = wl + WO_A2T; K = 64; Nsrc = 512; Ndst = 512; f16 = false; }
        else { r -= I_L64; src = ap->in[I_G2] + (size_t)l * 128 * 512; dst = wl + WO_G2T; K = 128; Nsrc = 512; Ndst = 512; f16 = false; }
        cvt_item(src, K, Nsrc, dst, ldw ? ldw : K, kind, gain, scr, r, Ndst / 32, C.lane, f16);
    }
    {
        float* tab = (float*)(ws + WS_TAB);
        const int gt = C.blk * 512 + C.tid, NT = C.G * 512;
        for (int i = gt; i < T * 40; i += NT) {
            const int t = i / 40, j = i % 40; float c, s;
            if (j < 32) { sincos_d((float)t * ap->inv_ret[j], c, s); tab[TAB_RCOS / 4 + t * 32 + j] = c; tab[TAB_RSIN / 4 + t * 32 + j] = s; }
            else { sincos_d((float)t * ap->inv_rot[j - 32], c, s); tab[TAB_PCOS / 4 + t * 8 + (j - 32)] = c; tab[TAB_PSIN / 4 + t * 8 + (j - 32)] = s; }
        }
    }
    {
        const float* x = ap->in[I_X]; bf16* xb = (bf16*)(ws + WS_XB); float* ss = (float*)(ws + WS_SS);
        for (int m0 = gw; m0 < M; m0 += 4 * NGW) {
            f32x4 v[4][4];
#pragma unroll
            for (int r = 0; r < 4; ++r) { const int m = m0 + r * NGW; const f32x4* xr = (const f32x4*)(x + (size_t)(m < M ? m : m0) * D) + C.lane;
#pragma unroll
                for (int j = 0; j < 4; ++j) v[r][j] = xr[64 * j]; }
#pragma unroll
            for (int r = 0; r < 4; ++r) { const int m = m0 + r * NGW; if (m < M) { u32x2* o = (u32x2*)(xb + (size_t)m * D) + C.lane; float s = 0.f;
#pragma unroll
                for (int j = 0; j < 4; ++j) { const f32x4 t = v[r][j]; s += (t[0] * t[0] + t[1] * t[1]) + (t[2] * t[2] + t[3] * t[3]); u32x2 w; w.x = pkh2(t[0], t[1]); w.y = pkh2(t[2], t[3]); o[64 * j] = w; }
                s = wave_sum(s);
                if (C.lane < 16) ss[(size_t)m * 16 + C.lane] = (C.lane == 0) ? s : 0.f; } }
        }
    }
}

template <int NH, bool SCALE> DI void stage_rope16(ldsp dst, int dstride, const bf16* src, int src_stride, int nrows, int pos0, const float* pcos, const float* psin, float scale, int tid) {
    const int ntask = nrows * NH * 7;
    for (int task = tid; task < ntask; task += 512) {
        const int c = task % 7, rh = task / 7, hh = rh % NH, r = rh / NH;
        const bf16* s = src + (size_t)r * src_stride + hh * 64; ldsp d = dst + r * dstride + hh * 128;
        if (c == 0) {
            const u32x4 xa = *(const u32x4*)s, xb = *(const u32x4*)(s + 8);
            const f32x4 c0 = *(const f32x4*)(pcos + (size_t)(pos0 + r) * 8), c1 = *(const f32x4*)(pcos + (size_t)(pos0 + r) * 8 + 4);
            const f32x4 s0 = *(const f32x4*)(psin + (size_t)(pos0 + r) * 8), s1 = *(const f32x4*)(psin + (size_t)(pos0 + r) * 8 + 4);
            const float cc[8] = {c0[0], c0[1], c0[2], c0[3], c1[0], c1[1], c1[2], c1[3]}; const float sn[8] = {s0[0], s0[1], s0[2], s0[3], s1[0], s1[1], s1[2], s1[3]};
            u32x4 oa, ob;
#pragma unroll
            for (int e = 0; e < 4; ++e) { const float a0 = lo_f(xa[e]), a1 = hi_f(xa[e]), b0 = lo_f(xb[e]), b1 = hi_f(xb[e]);
                float o10 = a0 * cc[2 * e] - b0 * sn[2 * e], o11 = a1 * cc[2 * e + 1] - b1 * sn[2 * e + 1], o20 = a0 * sn[2 * e] + b0 * cc[2 * e], o21 = a1 * sn[2 * e + 1] + b1 * cc[2 * e + 1];
                if (SCALE) { o10 *= scale; o11 *= scale; o20 *= scale; o21 *= scale; }
                oa[e] = pk2(o10, o11); ob[e] = pk2(o20, o21); }
            *(LAS u32x4*)d = oa; *(LAS u32x4*)(d + 16) = ob;
        } else {
            u32x4 x = *(const u32x4*)(s + 8 * (c + 1));
            if (SCALE) {
#pragma unroll
                for (int e = 0; e < 4; ++e) x[e] = pk2(lo_f(x[e]) * scale, hi_f(x[e]) * scale); }
            *(LAS u32x4*)(d + 16 * (c + 1)) = x;
        }
    }
}

struct RwkvP { const float *mu, *w0, *a0, *k_k, *k_a, *r_k; const bf16 *w2t, *a2t, *g2t; };
DI void rwkv_prep_item(const Ctx& C, const RwkvP& P, int item) {
    unsigned char* const ws = kargs()->ws;
    const bf16* proj = (const bf16*)(ws + WS_PROJ);
    const int tok0 = item * 16; const bool first = (tok0 % T) == 0;
    ldsp AL = C.lds;
    LAS float* LO = (LAS float*)(C.lds + 16384);
    constexpr int AST = 528, LOS = 1540;
    __syncthreads();
    {
        const int tk = C.tid >> 5, c8 = (C.tid & 31) * 8; const bf16* cur = proj + (size_t)(tok0 + tk) * NPROJ + C_RW + 1536 + c8;
        const u32x4 xc = *(const u32x4*)cur; u32x4 xp = {0u, 0u, 0u, 0u}; if (!(first && tk == 0)) xp = *(const u32x4*)(cur - NPROJ);
        u32x4 o;
#pragma unroll
        for (int e = 0; e < 4; ++e) { float v[2];
#pragma unroll
            for (int q = 0; q < 2; ++q) { const int col = c8 + 2 * e + q; const float c_ = q ? hi_f(xc[e]) : lo_f(xc[e]), p_ = q ? hi_f(xp[e]) : lo_f(xp[e]);
                float s = c_ + P.mu[1536 + col] * (p_ - c_);
                if (col < 64) s = tanhf_(s); else if (col >= 128) s = sigmoidf_(s);
                v[q] = s; }
            o[e] = pk2(v[0], v[1]); }
        *(LAS u32x4*)(AL + tk * AST + c8 * 2) = o;
    }
    __syncthreads();
    {
        const int fr = C.lane & 15, fq = C.lane >> 4;
#pragma unroll
        for (int seg = 0; seg < 3; ++seg) {
            const bf16* Bt = seg == 0 ? P.w2t : seg == 1 ? P.a2t : P.g2t; const int KS = seg == 2 ? 4 : 2, kbase = seg == 0 ? 0 : seg == 1 ? 64 : 128, ldb = seg == 2 ? 128 : 64;
#pragma unroll
            for (int ct = 0; ct < 4; ++ct) { f32x4 acc = {0.f, 0.f, 0.f, 0.f}; const int n = 64 * C.wave + 16 * ct + fr;
#pragma unroll
                for (int s = 0; s < 4; ++s) if (s < KS) { const bf16x8 af = lds_frag(AL + fr * AST + (kbase + 32 * s + 8 * fq) * 2); const bf16x8 bfr = *(const bf16x8*)(Bt + (size_t)n * ldb + 32 * s + 8 * fq);
                    acc = MFMA16(af, bfr, acc); }
#pragma unroll
                for (int j = 0; j < 4; ++j) LO[(4 * fq + j) * LOS + seg * 512 + n] = acc[j]; }
        }
    }
    __syncthreads();
    {
        const int col = C.tid, hh = C.wave;
        const float mr = P.mu[col], mk = P.mu[512 + col], mv = P.mu[1024 + col], w0 = P.w0[col], a0 = P.a0[col], kkc = P.k_k[col], kac = P.k_a[col], rkc = P.r_k[col];
        bf16* Pr = (bf16*)(ws + WS_PR); bf16* Pk = (bf16*)(ws + WS_PK); bf16* Pv = (bf16*)(ws + WS_PV); bf16* Pkk = (bf16*)(ws + WS_PKK); bf16* Pb = (bf16*)(ws + WS_PB);
        float* Pw = (float*)(ws + WS_PW); bf16* Pg = (bf16*)(ws + WS_PG); float* Pc = (float*)(ws + WS_PC);
        float pr = 0.f, pk = 0.f, pv = 0.f;
        if (!first) { const bf16* pp = proj + (size_t)(tok0 - 1) * NPROJ + C_RW + col; pr = bf2f(pp[0]); pk = bf2f(pp[512]); pv = bf2f(pp[1024]); }
#pragma unroll 2
        for (int tk = 0; tk < 16; ++tk) {
            const bf16* cp = proj + (size_t)(tok0 + tk) * NPROJ + C_RW + col; const float cr = bf2f(cp[0]), ck = bf2f(cp[512]), cv = bf2f(cp[1024]);
            const float rs = cr + mr * (pr - cr), ks = ck + mk * (pk - ck), vs = cv + mv * (pv - cv); pr = cr; pk = ck; pv = cv;
            const float dw = LO[tk * LOS + col], da = LO[tk * LOS + 512 + col], dg = LO[tk * LOS + 1024 + col];
            const float z = w0 + dw; const float sp = fmaxf(-z, 0.f) + __logf(1.f + __expf(-fabsf(z)));
            const float e = __expf(-sp - 0.5f); const float wdec = -e;
            const float eta = sigmoidf_(a0 + da);
            const float kkr = ks * kkc; const float n2 = wave_sum(kkr * kkr); const float kk = kkr * __builtin_amdgcn_rsqf(fmaxf(n2, 1e-24f));
            const float kp = ks * (1.f + (eta - 1.f) * kac); const float bb = kk * eta;
            const float cb = wave_sum(rs * kp * rkc);
            const size_t o = (size_t)(tok0 + tk) * 512 + col;
            Pr[o] = f2bf(rs); Pk[o] = f2bf(kp); Pv[o] = f2bf(vs); Pkk[o] = f2bf(kk); Pb[o] = f2bf(bb); Pw[o] = wdec; Pg[o] = f2bf(dg);
            if (C.lane == 0) Pc[(size_t)(tok0 + tk) * 8 + hh] = cb;
        }
    }
}

constexpr int IMS = 144, IMB = 64 * IMS;
template <bool SWAP> DI f32x4 mm16(ldsp X, int tx, ldsp Y, int ty, f32x4 acc, int fr, int fq) {
#pragma unroll
    for (int s = 0; s < 2; ++s) { const bf16x8 xf = lds_frag(X + (16 * tx + fr) * IMS + (32 * s + 8 * fq) * 2), yf = lds_frag(Y + (16 * ty + fr) * IMS + (32 * s + 8 * fq) * 2);
        acc = SWAP ? MFMA16(yf, xf, acc) : MFMA16(xf, yf, acc); }
    return acc;
}
DI void st_tile(ldsp img, int row, int col4, f32x4 v) { u32x2 w; w.x = pk2(v[0], v[1]); w.y = pk2(v[2], v[3]); *(LAS u32x2*)(img + row * IMS + col4 * 2) = w; }
DI f32x4 ld_tile(ldsp img, int row, int col4) { const u32x2 w = *(const LAS u32x2*)(img + row * IMS + col4 * 2); return (f32x4){lo_f(w.x), hi_f(w.x), lo_f(w.y), hi_f(w.y)}; }
DI void rwkv_pre_item(const Ctx& C, const RwkvP& P, int item) {
    unsigned char* const ws = kargs()->ws;
    const int chain = item / NRCH, c0 = (item % NRCH) * 64, bbh = chain >> 3, hh = chain & 7;
    const bf16* proj = (const bf16*)(ws + WS_PROJ);
    bf16* Pv = (bf16*)(ws + WS_PV); bf16* Pg = (bf16*)(ws + WS_PG); float* Pc = (float*)(ws + WS_PC);
    bf16* gG = (bf16*)(ws + WS_RG) + (size_t)item * 4096; bf16* gRP = (bf16*)(ws + WS_RRP) + (size_t)item * 4096; bf16* gH = (bf16*)(ws + WS_RH) + (size_t)item * 4096; float* gY0 = (float*)(ws + WS_RY0) + (size_t)item * 4096;
    ldsp L0 = C.lds;
    ldsp iAt = L0, iRt = L0 + IMB, iBt = L0 + 2 * IMB, iKt = L0 + 3 * IMB, iBpT = L0 + 4 * IMB, iKpT = L0 + 5 * IMB, iVT = L0 + 6 * IMB, iAtT = L0 + 7 * IMB,
         iAak = L0 + 8 * IMB, iArb = L0 + 9 * IMB, iArk = L0 + 10 * IMB, iX0 = L0 + 11 * IMB, iX1 = L0 + 12 * IMB, iX2 = L0 + 13 * IMB, iX3 = L0 + 14 * IMB;
    LAS float* SEG = (LAS float*)(L0 + 15 * IMB);
    const int fr = C.lane & 15, fq = C.lane >> 4, ti = C.wave >> 1, tj0 = 2 * (C.wave & 1);
    const size_t row0 = (size_t)bbh * T;
    ldsp iLw = L0, iLa = L0 + IMB, iLg0 = L0 + 2 * IMB, iLg1 = L0 + 3 * IMB, iW2 = L0 + 4 * IMB, iA2 = L0 + 5 * IMB, iG2a = L0 + 6 * IMB, iG2b = L0 + 7 * IMB;
    LAS float* LOw = (LAS float*)(L0 + 8 * IMB); LAS float* LOa = LOw + 64 * 68; LAS float* LOg = LOa + 64 * 68;
    __syncthreads();
    {
        const int k = C.tid & 63, seg = C.tid >> 6; const size_t tokb = row0 + c0 + 8 * seg;
        const bool first = (c0 == 0 && seg == 0);
        float lw[8], cs[8], kkv[8], bv[8], kv[8], rv[8], vv[8];
        {
            const bf16* pb = proj + tokb * NPROJ + C_RW + hh * 64 + k;
            const bf16* pl = proj + tokb * NPROJ + C_RW + 1536 + k;
            float pr = 0.f, pk = 0.f, pvv = 0.f, pw = 0.f, pa = 0.f, pg0 = 0.f, pg1 = 0.f;
            if (!first) { pr = bf2f(pb[-NPROJ]); pk = bf2f(pb[512 - NPROJ]); pvv = bf2f(pb[1024 - NPROJ]); pw = bf2f(pl[-NPROJ]); pa = bf2f(pl[64 - NPROJ]); pg0 = bf2f(pl[128 - NPROJ]); pg1 = bf2f(pl[192 - NPROJ]); }
            const float mr = P.mu[hh * 64 + k], mk = P.mu[512 + hh * 64 + k], mv = P.mu[1024 + hh * 64 + k], mw = P.mu[1536 + k], ma = P.mu[1600 + k], mg0 = P.mu[1664 + k], mg1 = P.mu[1728 + k];
#pragma unroll
            for (int i = 0; i < 8; ++i) { const size_t o = (size_t)i * NPROJ; const int t = 8 * seg + i;
                const float cr = bf2f(pb[o]), ck = bf2f(pb[o + 512]), cv = bf2f(pb[o + 1024]), cw = bf2f(pl[o]), ca = bf2f(pl[o + 64]), cg0 = bf2f(pl[o + 128]), cg1 = bf2f(pl[o + 192]);
                rv[i] = cr + mr * (pr - cr); kv[i] = ck + mk * (pk - ck); vv[i] = cv + mv * (pvv - cv);
                *(LAS bf16*)(iLw + t * IMS + k * 2) = f2bf(tanhf_(cw + mw * (pw - cw))); *(LAS bf16*)(iLa + t * IMS + k * 2) = f2bf(ca + ma * (pa - ca));
                *(LAS bf16*)(iLg0 + t * IMS + k * 2) = f2bf(sigmoidf_(cg0 + mg0 * (pg0 - cg0))); *(LAS bf16*)(iLg1 + t * IMS + k * 2) = f2bf(sigmoidf_(cg1 + mg1 * (pg1 - cg1)));
                pr = cr; pk = ck; pvv = cv; pw = cw; pa = ca; pg0 = cg0; pg1 = cg1; }
            const int wrow = C.tid >> 3, wch = (C.tid & 7) * 8;
            *(LAS u32x4*)(iW2 + wrow * IMS + wch * 2) = *(const u32x4*)(P.w2t + (size_t)(hh * 64 + wrow) * 64 + wch); *(LAS u32x4*)(iA2 + wrow * IMS + wch * 2) = *(const u32x4*)(P.a2t + (size_t)(hh * 64 + wrow) * 64 + wch);
            *(LAS u32x4*)(iG2a + wrow * IMS + wch * 2) = *(const u32x4*)(P.g2t + (size_t)(hh * 64 + wrow) * 128 + wch); *(LAS u32x4*)(iG2b + wrow * IMS + wch * 2) = *(const u32x4*)(P.g2t + (size_t)(hh * 64 + wrow) * 128 + 64 + wch);
        }
        __syncthreads();
#pragma unroll
        for (int e = 0; e < 2; ++e) { const int tj = tj0 + e; const f32x4 z = {0.f, 0.f, 0.f, 0.f}; const int rr = 16 * ti + fr, cc = 16 * tj + 4 * fq;
            *(LAS f32x4*)(LOw + rr * 68 + cc) = mm16<true>(iLw, ti, iW2, tj, z, fr, fq); *(LAS f32x4*)(LOa + rr * 68 + cc) = mm16<true>(iLa, ti, iA2, tj, z, fr, fq);
            f32x4 g = mm16<true>(iLg0, ti, iG2a, tj, z, fr, fq); g = mm16<true>(iLg1, ti, iG2b, tj, g, fr, fq); *(LAS f32x4*)(LOg + rr * 68 + cc) = g; }
        __syncthreads();
        float run = 0.f;
        {
            const int col = hh * 64 + k; const float w0 = P.w0[col], a0 = P.a0[col], kkc = P.k_k[col], kac = P.k_a[col], rkc = P.r_k[col];
#pragma unroll
            for (int i = 0; i < 8; ++i) { const int t = 8 * seg + i; const float dw = LOw[t * 68 + k], da = LOa[t * 68 + k], dg = LOg[t * 68 + k];
                const float z = w0 + dw; const float sp = fmaxf(-z, 0.f) + __logf(1.f + __expf(-fabsf(z)));
                lw[i] = -__expf(-sp - 0.5f); run += lw[i]; cs[i] = run;
                const float eta = sigmoidf_(a0 + da);
                const float kkr = kv[i] * kkc; const float n2 = wave_sum(kkr * kkr); kkv[i] = kkr * __builtin_amdgcn_rsqf(fmaxf(n2, 1e-24f));
                kv[i] = kv[i] * (1.f + (eta - 1.f) * kac); bv[i] = kkv[i] * eta;
                const float cb = wave_sum(rv[i] * kv[i] * rkc);
                const size_t og = (tokb + i) * 512 + col; Pv[og] = f2bf(vv[i]); Pg[og] = f2bf(dg); if (C.lane == 0) Pc[(tokb + i) * 8 + hh] = cb; }
        }
        __syncthreads();
        SEG[seg * 64 + k] = run;
        __syncthreads();
        float pre = 0.f, tot = 0.f;
#pragma unroll
        for (int s2 = 0; s2 < 8; ++s2) { const float x = SEG[s2 * 64 + k]; tot += x; if (s2 < seg) pre += x; }
        u32x4 wbp, wkp, wvt, wat; float bp[8], kp[8], at[8];
#pragma unroll
        for (int i = 0; i < 8; ++i) { const float lgi = pre + cs[i]; const float gi = __expf(lgi), gx = __expf(lgi - lw[i]), ginv = __expf(-lgi), gc = __expf(tot - lgi);
            const int t = 8 * seg + i; at[i] = -kkv[i] * gx;
            *(LAS bf16*)(iAt + t * IMS + k * 2) = f2bf(at[i]); *(LAS bf16*)(iRt + t * IMS + k * 2) = f2bf(rv[i] * gi);
            *(LAS bf16*)(iBt + t * IMS + k * 2) = f2bf(bv[i] * ginv); *(LAS bf16*)(iKt + t * IMS + k * 2) = f2bf(kv[i] * ginv);
            bp[i] = bv[i] * gc; kp[i] = kv[i] * gc; }
#pragma unroll
        for (int e = 0; e < 4; ++e) { wbp[e] = pk2(bp[2 * e], bp[2 * e + 1]); wkp[e] = pk2(kp[2 * e], kp[2 * e + 1]); wvt[e] = pk2(vv[2 * e], vv[2 * e + 1]); wat[e] = pk2(at[2 * e], at[2 * e + 1]); }
        *(LAS u32x4*)(iBpT + k * IMS + 16 * seg) = wbp; *(LAS u32x4*)(iKpT + k * IMS + 16 * seg) = wkp; *(LAS u32x4*)(iVT + k * IMS + 16 * seg) = wvt; *(LAS u32x4*)(iAtT + k * IMS + 16 * seg) = wat;
        if (seg == 0) SEG[512 + k] = __expf(tot);
    }
    __syncthreads();
    {
#pragma unroll
        for (int e = 0; e < 2; ++e) { const int tj = tj0 + e; const f32x4 z = {0.f, 0.f, 0.f, 0.f};
            f32x4 lab = mm16<true>(iAt, ti, iBt, tj, z, fr, fq), lak = mm16<true>(iAt, ti, iKt, tj, z, fr, fq), lrb = mm16<true>(iRt, ti, iBt, tj, z, fr, fq), lrk = mm16<true>(iRt, ti, iKt, tj, z, fr, fq);
            f32x4 labT = mm16<false>(iAt, ti, iBt, tj, z, fr, fq);
            const int t = 16 * ti + fr; f32x4 m1;
#pragma unroll
            for (int i = 0; i < 4; ++i) { const int j = 16 * tj + 4 * fq + i; if (!(j < t)) { lab[i] = 0.f; lak[i] = 0.f; } if (!(j <= t)) { lrb[i] = 0.f; lrk[i] = 0.f; } m1[i] = lab[i] + ((j == t) ? 1.f : 0.f); }
#pragma unroll
            for (int i = 0; i < 4; ++i) { const int tt = 16 * ti + 4 * fq + i, jj = 16 * tj + fr; if (!(jj < tt)) labT[i] = 0.f; }
            st_tile(iX0, t, 16 * tj + 4 * fq, lab); st_tile(iX1, 16 * tj + fr, 16 * ti + 4 * fq, labT); st_tile(iX2, t, 16 * tj + 4 * fq, m1);
            st_tile(iAak, t, 16 * tj + 4 * fq, lak); st_tile(iArb, t, 16 * tj + 4 * fq, lrb); st_tile(iArk, t, 16 * tj + 4 * fq, lrk); }
    }
    __syncthreads();
    ldsp Pn = iX0, Pt = iX1, Qn = iBt, Qt = iKt, Mc = iX2, Mn = iX3;
#pragma unroll 1
    for (int lev = 0; lev < 6; ++lev) {
#pragma unroll
        for (int e = 0; e < 2; ++e) { const int tj = tj0 + e; const f32x4 z = {0.f, 0.f, 0.f, 0.f};
            if (lev < 5) { const f32x4 q = mm16<true>(Pn, ti, Pt, tj, z, fr, fq), qT = mm16<false>(Pn, ti, Pt, tj, z, fr, fq);
                st_tile(Qn, 16 * ti + fr, 16 * tj + 4 * fq, q); st_tile(Qt, 16 * tj + fr, 16 * ti + 4 * fq, qT); }
            if (lev > 0) { f32x4 m = mm16<true>(Mc, ti, Pt, tj, z, fr, fq); m += ld_tile(Mc, 16 * ti + fr, 16 * tj + 4 * fq); st_tile(Mn, 16 * ti + fr, 16 * tj + 4 * fq, m); } }
        __syncthreads();
        if (lev > 0) { ldsp x = Mc; Mc = Mn; Mn = x; }
        if (lev < 5) { ldsp x = Pn; Pn = Qn; Qn = x; x = Pt; Pt = Qt; Qt = x; }
    }
    ldsp iPT = Mn, iWT = Qn, iQT = Qt;
#pragma unroll
    for (int e = 0; e < 2; ++e) { const int tj = tj0 + e; const f32x4 z = {0.f, 0.f, 0.f, 0.f};
        st_tile(iPT, 16 * ti + fr, 16 * tj + 4 * fq, mm16<true>(iAtT, ti, Mc, tj, z, fr, fq));
        st_tile(iWT, 16 * ti + fr, 16 * tj + 4 * fq, mm16<true>(iVT, ti, iAak, tj, z, fr, fq)); }
    __syncthreads();
#pragma unroll
    for (int e = 0; e < 2; ++e) { const int tj = tj0 + e; const f32x4 z = {0.f, 0.f, 0.f, 0.f}; const int rr = 16 * ti + fr, cc = 16 * tj + 4 * fq;
        st_tile(iQT, rr, cc, mm16<true>(iWT, ti, Mc, tj, z, fr, fq));
        f32x4 rp = mm16<true>(iArb, ti, iPT, tj, z, fr, fq); rp += ld_tile(iRt, rr, cc);
        { u32x2 w; w.x = pk2(rp[0], rp[1]); w.y = pk2(rp[2], rp[3]); *(u32x2*)(gRP + rr * 64 + cc) = w; }
        f32x4 g = mm16<true>(iBpT, ti, iPT, tj, z, fr, fq);
#pragma unroll
        for (int i = 0; i < 4; ++i) if (cc + i == rr) g[i] += SEG[512 + rr];
        { u32x2 w; w.x = pk2(g[0], g[1]); w.y = pk2(g[2], g[3]); *(u32x2*)(gG + rr * 64 + cc) = w; } }
    __syncthreads();
#pragma unroll
    for (int e = 0; e < 2; ++e) { const int tj = tj0 + e; const int rr = 16 * ti + fr, cc = 16 * tj + 4 * fq;
        f32x4 y0 = {0.f, 0.f, 0.f, 0.f}; y0 = mm16<true>(iArb, ti, iQT, tj, y0, fr, fq); y0 = mm16<true>(iArk, ti, iVT, tj, y0, fr, fq); *(f32x4*)(gY0 + rr * 64 + cc) = y0;
        f32x4 h = {0.f, 0.f, 0.f, 0.f}; h = mm16<true>(iQT, ti, iBpT, tj, h, fr, fq); h = mm16<true>(iVT, ti, iKpT, tj, h, fr, fq);
        { u32x2 w; w.x = pk2(h[0], h[1]); w.y = pk2(h[2], h[3]); *(u32x2*)(gH + rr * 64 + cc) = w; } }
}
DI void rwkv_state_chain(const Ctx& C, int chain) {
    unsigned char* const ws = kargs()->ws;
    const bf16* gG = (const bf16*)(ws + WS_RG) + (size_t)chain * NRCH * 4096; const bf16* gH = (const bf16*)(ws + WS_RH) + (size_t)chain * NRCH * 4096; bf16* gS = (bf16*)(ws + WS_RSC) + (size_t)chain * NRCH * 4096;
    ldsp iSb = C.lds, iG = C.lds + IMB;
    const int fr = C.lane & 15, fq = C.lane >> 4, ti = C.wave >> 1, tj0 = 2 * (C.wave & 1);
    f32x4 st[2] = {{0.f, 0.f, 0.f, 0.f}, {0.f, 0.f, 0.f, 0.f}};
    const int grow = C.tid >> 3, gch = (C.tid & 7) * 8;
    u32x4 gpre = *(const u32x4*)(gG + grow * 64 + gch);
    u32x2 hpre[2];
#pragma unroll
    for (int e = 0; e < 2; ++e) hpre[e] = *(const u32x2*)(gH + (16 * ti + fr) * 64 + 16 * (tj0 + e) + 4 * fq);
#pragma unroll 1
    for (int c = 0; c < NRCH; ++c) {
        __syncthreads();
#pragma unroll
        for (int e = 0; e < 2; ++e) { u32x2 w; w.x = pk2(st[e][0], st[e][1]); w.y = pk2(st[e][2], st[e][3]);
            *(LAS u32x2*)(iSb + (16 * ti + fr) * IMS + (16 * (tj0 + e) + 4 * fq) * 2) = w; *(u32x2*)(gS + (size_t)c * 4096 + (16 * ti + fr) * 64 + 16 * (tj0 + e) + 4 * fq) = w; }
        if (c == NRCH - 1) break;
        *(LAS u32x4*)(iG + grow * IMS + gch * 2) = gpre;
        u32x2 hw[2];
#pragma unroll
        for (int e = 0; e < 2; ++e) hw[e] = hpre[e];
        gpre = *(const u32x4*)(gG + (size_t)(c + 1) * 4096 + grow * 64 + gch);
#pragma unroll
        for (int e = 0; e < 2; ++e) hpre[e] = *(const u32x2*)(gH + (size_t)(c + 1) * 4096 + (16 * ti + fr) * 64 + 16 * (tj0 + e) + 4 * fq);
        __syncthreads();
#pragma unroll
        for (int e = 0; e < 2; ++e) { f32x4 sn = {lo_f(hw[e].x), hi_f(hw[e].x), lo_f(hw[e].y), hi_f(hw[e].y)}; sn = mm16<true>(iSb, ti, iG, tj0 + e, sn, fr, fq); st[e] = sn; }
    }
}
struct RwkvOutPre { u32x4 rp, sc, xv, xg; f32x4 y0[2]; float cb; };
DI void rwkv_out_load(const Ctx& C, int item, RwkvOutPre& P) {
    unsigned char* const ws = kargs()->ws;
    const int chain = item / NRCH, c0 = (item % NRCH) * 64, bbh = chain >> 3, hh = chain & 7;
    const bf16* gRP = (const bf16*)(ws + WS_RRP) + (size_t)item * 4096; const bf16* gS = (const bf16*)(ws + WS_RSC) + (size_t)item * 4096; const float* gY0 = (const float*)(ws + WS_RY0) + (size_t)item * 4096;
    const bf16* Pv = (const bf16*)(ws + WS_PV); const bf16* Pg = (const bf16*)(ws + WS_PG); const float* Pc = (const float*)(ws + WS_PC);
    const int fr = C.lane & 15, fq = C.lane >> 4, ti = C.wave >> 1, tj0 = 2 * (C.wave & 1);
    const int grow = C.tid >> 3, gch = (C.tid & 7) * 8;
    P.rp = *(const u32x4*)(gRP + grow * 64 + gch); P.sc = *(const u32x4*)(gS + grow * 64 + gch);
#pragma unroll
    for (int e = 0; e < 2; ++e) P.y0[e] = *(const f32x4*)(gY0 + (16 * ti + fr) * 64 + 16 * (tj0 + e) + 4 * fq);
    const int t = C.tid >> 3, v8 = (C.tid & 7) * 8; const size_t tok = (size_t)bbh * T + c0 + t;
    P.xv = *(const u32x4*)(Pv + tok * 512 + hh * 64 + v8); P.xg = *(const u32x4*)(Pg + tok * 512 + hh * 64 + v8); P.cb = Pc[tok * 8 + hh];
}
DI void rwkv_out_items(const Ctx& C, int lo, int hi, const float* ln_w, const float* ln_b) {
    if (lo >= hi) return;
    unsigned char* const ws = kargs()->ws;
    bf16* yo = (bf16*)(ws + WS_YDR) + 512;
    ldsp iRP = C.lds, iSc = C.lds + IMB; LAS float* YL = (LAS float*)(C.lds + 2 * IMB);
    const int fr = C.lane & 15, fq = C.lane >> 4, ti = C.wave >> 1, tj0 = 2 * (C.wave & 1);
    const int grow = C.tid >> 3, gch = (C.tid & 7) * 8;
    RwkvOutPre N; rwkv_out_load(C, lo, N);
#pragma unroll 1
    for (int item = lo; item < hi; ++item) {
        const int chain = item / NRCH, c0 = (item % NRCH) * 64, bbh = chain >> 3, hh = chain & 7;
        const RwkvOutPre P = N;
        __syncthreads();
        *(LAS u32x4*)(iRP + grow * IMS + gch * 2) = P.rp; *(LAS u32x4*)(iSc + grow * IMS + gch * 2) = P.sc;
        if (item + 1 < hi) rwkv_out_load(C, item + 1, N);
        __syncthreads();
#pragma unroll
        for (int e = 0; e < 2; ++e) { const int tj = tj0 + e; const int rr = 16 * ti + fr, cc = 16 * tj + 4 * fq;
            f32x4 y = P.y0[e]; y = mm16<true>(iRP, ti, iSc, tj, y, fr, fq); *(LAS f32x4*)(YL + rr * 68 + cc) = y; }
        __syncthreads();
        {
            const int t = C.tid >> 3, v8 = (C.tid & 7) * 8; const size_t tok = (size_t)bbh * T + c0 + t;
            const f32x4 ya = *(const LAS f32x4*)(YL + t * 68 + v8), yb = *(const LAS f32x4*)(YL + t * 68 + v8 + 4);
            float y[8] = {ya[0], ya[1], ya[2], ya[3], yb[0], yb[1], yb[2], yb[3]};
            float sm = ((y[0] + y[1]) + (y[2] + y[3])) + ((y[4] + y[5]) + (y[6] + y[7])); sm += dppf<0xB1>(sm); sm += dppf<0x4E>(sm); sm += dppf<0x141>(sm);
            const float mean = sm * (1.f / 64.f); float sq = 0.f;
#pragma unroll
            for (int i = 0; i < 8; ++i) { y[i] -= mean; sq += y[i] * y[i]; }
            sq += dppf<0xB1>(sq); sq += dppf<0x4E>(sq); sq += dppf<0x141>(sq);
            const float rstd = __builtin_amdgcn_rsqf(sq * (1.f / 64.f) + 64e-5f);
            const u32x4 xv = P.xv, xg = P.xg; const float cb = P.cb;
            const f32x4 lw0 = *(const f32x4*)(ln_w + hh * 64 + v8), lw1 = *(const f32x4*)(ln_w + hh * 64 + v8 + 4), lb0 = *(const f32x4*)(ln_b + hh * 64 + v8), lb1 = *(const f32x4*)(ln_b + hh * 64 + v8 + 4);
            const float lw[8] = {lw0[0], lw0[1], lw0[2], lw0[3], lw1[0], lw1[1], lw1[2], lw1[3]}, lb[8] = {lb0[0], lb0[1], lb0[2], lb0[3], lb1[0], lb1[1], lb1[2], lb1[3]};
            u32x4 o;
#pragma unroll
            for (int e = 0; e < 4; ++e) { const float v0 = lo_f(xv[e]), v1 = hi_f(xv[e]), g0 = lo_f(xg[e]), g1 = hi_f(xg[e]);
                const float o0 = (y[2 * e] * rstd * lw[2 * e] + lb[2 * e] + cb * v0) * g0, o1 = (y[2 * e + 1] * rstd * lw[2 * e + 1] + lb[2 * e + 1] + cb * v1) * g1; o[e] = pkh2(o0, o1); }
            *(u32x4*)(yo + tok * 1024 + hh * 64 + v8) = o;
        }
    }
}

template <bool WANT_Q, bool WANT_K, bool WANT_KDT> DI void ret_stage(const Ctx& C, const bf16* proj, size_t row0, int ch, int hh, float lg2, const float* rcos, const float* rsin, ldsp Qs, ldsp Ks, ldsp KdT, ldsp VT) {
    constexpr int QST = 144, TST = 272;
    {
        const int i = C.tid >> 2, p0 = (C.tid & 3) * 8; const int pos = ch * 128 + i;
        const f32x4 c0 = *(const f32x4*)(rcos + pos * 32 + p0), c1 = *(const f32x4*)(rcos + pos * 32 + p0 + 4), s0 = *(const f32x4*)(rsin + pos * 32 + p0), s1 = *(const f32x4*)(rsin + pos * 32 + p0 + 4);
        const float cc[8] = {c0[0], c0[1], c0[2], c0[3], c1[0], c1[1], c1[2], c1[3]}; const float sn[8] = {s0[0], s0[1], s0[2], s0[3], s1[0], s1[1], s1[2], s1[3]};
        if (WANT_Q) { const bf16* qp = proj + (row0 + i) * NPROJ + C_RQ + hh * 64 + p0; const u32x4 qa = *(const u32x4*)qp, qb = *(const u32x4*)(qp + 32); u32x4 oqa, oqb;
#pragma unroll
            for (int e = 0; e < 4; ++e) { const float q10 = lo_f(qa[e]), q11 = hi_f(qa[e]), q20 = lo_f(qb[e]), q21 = hi_f(qb[e]);
                oqa[e] = pk2(q10 * cc[2 * e] - q20 * sn[2 * e], q11 * cc[2 * e + 1] - q21 * sn[2 * e + 1]); oqb[e] = pk2(q10 * sn[2 * e] + q20 * cc[2 * e], q11 * sn[2 * e + 1] + q21 * cc[2 * e + 1]); }
            *(LAS u32x4*)(Qs + i * QST + p0 * 2) = oqa; *(LAS u32x4*)(Qs + i * QST + (32 + p0) * 2) = oqb; }
        if (WANT_K || WANT_KDT) { const bf16* kp = proj + (row0 + i) * NPROJ + C_RK + hh * 64 + p0; const u32x4 ka = *(const u32x4*)kp, kb = *(const u32x4*)(kp + 32);
            const float kd = ex2((float)(127 - i) * lg2); u32x4 oka, okb;
#pragma unroll
            for (int e = 0; e < 4; ++e) { const float k10 = lo_f(ka[e]), k11 = hi_f(ka[e]), k20 = lo_f(kb[e]), k21 = hi_f(kb[e]);
                const float r10 = (k10 * cc[2 * e] - k20 * sn[2 * e]) * 0.125f, r11 = (k11 * cc[2 * e + 1] - k21 * sn[2 * e + 1]) * 0.125f;
                const float r20 = (k10 * sn[2 * e] + k20 * cc[2 * e]) * 0.125f, r21 = (k11 * sn[2 * e + 1] + k21 * cc[2 * e + 1]) * 0.125f;
                oka[e] = pk2(r10, r11); okb[e] = pk2(r20, r21);
                if (WANT_KDT) { *(LAS bf16*)(KdT + (p0 + 2 * e) * TST + i * 2) = f2bf(r10 * kd); *(LAS bf16*)(KdT + (p0 + 2 * e + 1) * TST + i * 2) = f2bf(r11 * kd);
                    *(LAS bf16*)(KdT + (32 + p0 + 2 * e) * TST + i * 2) = f2bf(r20 * kd); *(LAS bf16*)(KdT + (32 + p0 + 2 * e + 1) * TST + i * 2) = f2bf(r21 * kd); } }
            if (WANT_K) { *(LAS u32x4*)(Ks + i * QST + p0 * 2) = oka; *(LAS u32x4*)(Ks + i * QST + (32 + p0) * 2) = okb; } }
#pragma unroll
        for (int rep = 0; rep < 4; ++rep) { const int task = C.tid + 512 * rep, j = task >> 4, d0 = (task & 15) * 8;
            const u32x4 xv = *(const u32x4*)(proj + (row0 + j) * NPROJ + C_RV + hh * 128 + d0);
#pragma unroll
            for (int e = 0; e < 4; ++e) { *(LAS bf16*)(VT + (d0 + 2 * e) * TST + j * 2) = (bf16)(xv[e] & 0xffffu); *(LAS bf16*)(VT + (d0 + 2 * e + 1) * TST + j * 2) = (bf16)(xv[e] >> 16); } }
    }
}
DI void ret_state_item(const Ctx& C, int bh, int ch, const float* rcos, const float* rsin) {
    unsigned char* const ws = kargs()->ws;
    const int bbh = bh >> 3, hh = bh & 7; const bf16* proj = (const bf16*)(ws + WS_PROJ); bf16* gU = (bf16*)(ws + WS_RU) + ((size_t)bh * 16 + ch) * 8192;
    constexpr int TST = 272; ldsp KdT = C.lds, VT = KdT + 64 * TST;
    const float lg2 = ret_lg2(hh);
    const int lr = C.lane & 31, hi = C.lane >> 5, wq = C.wave >> 1, wp = C.wave & 1;
    const size_t row0 = (size_t)bbh * T + ch * 128;
    __syncthreads();
    ret_stage<false, false, true>(C, proj, row0, ch, hh, lg2, rcos, rsin, KdT, KdT, KdT, VT);
    __syncthreads();
    f32x16 st;
#pragma unroll
    for (int r = 0; r < 16; ++r) st[r] = 0.f;
#pragma unroll 2
    for (int s = 0; s < 8; ++s) st = MFMA32(lds_frag(VT + (32 * wq + lr) * TST + (16 * s + 8 * hi) * 2), lds_frag(KdT + (32 * wp + lr) * TST + (16 * s + 8 * hi) * 2), st);
#pragma unroll
    for (int r = 0; r < 16; ++r) gU[(32 * wq + crow(r, hi)) * 64 + 32 * wp + lr] = f2bf(st[r]);
}
#ifndef DUP_PHASE
#define DUP_PHASE -1
#endif
#define REPX(k) for (int repx = 0; repx < ((DUP_PHASE == (k)) ? 2 : 1); ++repx)
DI bf16x8 frag_sw(ldsp tile, int row, int c) { return *(const LAS bf16x8*)(tile + row * 128 + ((c ^ (row & 7)) << 4)); }
template <int ROWS> DI void dma_tile64(ldsp dst, const bf16* src, size_t src_stride, int wave, int lane) {
#pragma unroll
    for (int g0 = 0; g0 < ROWS / 8; g0 += 8) { const int g = g0 + wave; const int row = g * 8 + (lane >> 3), c = (lane & 7) ^ (row & 7);
        __builtin_amdgcn_global_load_lds((const unsigned*)(src + (size_t)row * src_stride + 8 * c), (LAS unsigned*)(dst + g * 1024), 16, 0, 0); }
}
DI void ret_prep(const Ctx& C, const float* rcos, const float* rsin) {
    unsigned char* const ws = kargs()->ws; const bf16* proj = (const bf16*)(ws + WS_PROJ);
    bf16* qr = (bf16*)(ws + WS_RQR); bf16* kr = (bf16*)(ws + WS_RKR); bf16* vT = (bf16*)(ws + WS_RVT);
    const int gt = C.blk * 512 + C.tid, NT = C.G * 512;
    for (int task = gt; task < MG * 16; task += NT) {
        const int tok = task >> 4, hq = task & 15, hh = hq & 7, isk = hq >> 3, pos = tok % T;
        const bf16* src = proj + (size_t)tok * NPROJ + (isk ? C_RK : C_RQ) + hh * 64; bf16* dst = (isk ? kr : qr) + (size_t)tok * 512 + hh * 64; const float sc = isk ? 0.125f : 1.f;
#pragma unroll
        for (int c = 0; c < 4; ++c) { const u32x4 xa = *(const u32x4*)(src + 8 * c), xb = *(const u32x4*)(src + 32 + 8 * c);
            const f32x4 c0 = *(const f32x4*)(rcos + pos * 32 + 8 * c), c1 = *(const f32x4*)(rcos + pos * 32 + 8 * c + 4), s0 = *(const f32x4*)(rsin + pos * 32 + 8 * c), s1 = *(const f32x4*)(rsin + pos * 32 + 8 * c + 4);
            const float cc[8] = {c0[0], c0[1], c0[2], c0[3], c1[0], c1[1], c1[2], c1[3]}; const float sn[8] = {s0[0], s0[1], s0[2], s0[3], s1[0], s1[1], s1[2], s1[3]};
            u32x4 oa, ob;
#pragma unroll
            for (int e = 0; e < 4; ++e) { const float a0 = lo_f(xa[e]), a1 = hi_f(xa[e]), b0 = lo_f(xb[e]), b1 = hi_f(xb[e]);
                oa[e] = pk2((a0 * cc[2 * e] - b0 * sn[2 * e]) * sc, (a1 * cc[2 * e + 1] - b1 * sn[2 * e + 1]) * sc); ob[e] = pk2((a0 * sn[2 * e] + b0 * cc[2 * e]) * sc, (a1 * sn[2 * e + 1] + b1 * cc[2 * e + 1]) * sc); }
            *(u32x4*)(dst + 8 * c) = oa; *(u32x4*)(dst + 32 + 8 * c) = ob; }
    }
    const int gw = C.blk * 8 + C.wave, NGW = C.G * 8;
    for (int wt = gw; wt < (MG / 64) * 128; wt += NGW) { const int tok = (wt >> 7) * 64 + C.lane, hd = wt & 127, hh = hd >> 4, dc = hd & 15, bb = tok / T, pos = tok % T;
        const u32x4 xv = *(const u32x4*)(proj + (size_t)tok * NPROJ + C_RV + hh * 128 + 8 * dc);
#pragma unroll
        for (int e = 0; e < 4; ++e) { vT[((size_t)(bb * 8 + hh) * 128 + 8 * dc + 2 * e) * T + pos] = (bf16)(xv[e] & 0xffffu); vT[((size_t)(bb * 8 + hh) * 128 + 8 * dc + 2 * e + 1) * T + pos] = (bf16)(xv[e] >> 16); } }
}
template <int ROWS> DI void dma_tile128(ldsp dst, const bf16* src, size_t src_stride, int wave, int lane) {
#pragma unroll
    for (int g0 = 0; g0 < ROWS / 4; g0 += 8) { const int g = g0 + wave; const int row = g * 4 + (lane >> 4), c = (lane & 15) ^ (row & 7);
        __builtin_amdgcn_global_load_lds((const unsigned*)(src + (size_t)row * src_stride + 8 * c), (LAS unsigned*)(dst + g * 1024), 16, 0, 0); }
}
DI bf16x8 frag128(ldsp tile, int row, int c) { return *(const LAS bf16x8*)(tile + row * 256 + ((c ^ (row & 7)) << 4)); }
DI void ret_scan(const Ctx& C) {
    unsigned char* const ws = kargs()->ws;
    if (C.tid >= 128) return;
    const int e = C.blk + C.G * C.tid;
    if (e >= BG * 8 * 1024) return;
    const int bh = e >> 10, off = (e & 1023) * 8; const float g128 = ex2(128.f * ret_lg2(bh & 7));
    const bf16* gU = (const bf16*)(ws + WS_RU) + (size_t)bh * 16 * 8192 + off; bf16* gS = (bf16*)(ws + WS_RS) + (size_t)bh * 16 * 8192 + off;
    u32x4 uv[15];
#pragma unroll
    for (int c = 0; c < 15; ++c) uv[c] = *(const u32x4*)(gU + (size_t)c * 8192);
    float st[8];
#pragma unroll
    for (int k = 0; k < 8; ++k) st[k] = 0.f;
#pragma unroll
    for (int c = 0; c < 15; ++c) { u32x4 o;
#pragma unroll
        for (int k = 0; k < 4; ++k) { st[2 * k] = g128 * st[2 * k] + lo_f(uv[c][k]); st[2 * k + 1] = g128 * st[2 * k + 1] + hi_f(uv[c][k]); o[k] = pk2(st[2 * k], st[2 * k + 1]); }
        *(u32x4*)(gS + (size_t)(c + 1) * 8192) = o; }
}
DI void ret_out_stage(const Ctx& C, int bh, int ch, ldsp Qs, ldsp Ks, ldsp VT, u32x4& sa, u32x4& sb) {
    unsigned char* const ws = kargs()->ws;
    const bf16* qr = (const bf16*)(ws + WS_RQR); const bf16* kr = (const bf16*)(ws + WS_RKR); const bf16* vT = (const bf16*)(ws + WS_RVT);
    const int bbh = bh >> 3, hh = bh & 7; const size_t row0 = (size_t)bbh * T + ch * 128;
    dma_tile64<128>(Qs, qr + row0 * 512 + hh * 64, 512, C.wave, C.lane); dma_tile64<128>(Ks, kr + row0 * 512 + hh * 64, 512, C.wave, C.lane);
    dma_tile128<128>(VT, vT + (size_t)bh * 128 * T + ch * 128, T, C.wave, C.lane);
    const int dv = C.tid >> 2, dk0 = (C.tid & 3) * 16; sa = (u32x4){0u, 0u, 0u, 0u}; sb = (u32x4){0u, 0u, 0u, 0u};
    if (ch > 0) { const bf16* gS = (const bf16*)(ws + WS_RS) + ((size_t)bh * 16 + ch) * 8192 + dv * 64 + dk0; sa = *(const u32x4*)gS; sb = *(const u32x4*)(gS + 8); }
}
DI void ret_out_items(const Ctx& C, int lo, int hi) {
    if (lo >= hi) return;
    unsigned char* const ws = kargs()->ws;
    const bf16* proj = (const bf16*)(ws + WS_PROJ); bf16* yret = (bf16*)(ws + WS_YRET);
    constexpr int PST = 272, SST = 144;
    ldsp Qs = C.lds, Ks = Qs + 16384, VT = Ks + 16384, Ps = VT + 32768, STb = Ps + 128 * PST; LAS float* SSQ = (LAS float*)(STb + 128 * SST);
    const int lr = C.lane & 31, hi5 = C.lane >> 5, wq = C.wave >> 1, wp = C.wave & 1;
    const int i = 32 * wq + lr;
    const int sdv = C.tid >> 2, sdk0 = (C.tid & 3) * 16;
    u32x4 sa, sb;
    __syncthreads();
    ret_out_stage(C, lo % (BG * 8), lo / (BG * 8), Qs, Ks, VT, sa, sb);
#pragma unroll 1
    for (int item = lo; item < hi; ++item) {
        const int bh = item % (BG * 8), ch = item / (BG * 8), bbh = bh >> 3, hh = bh & 7;
        const float lg2 = ret_lg2(hh);
        const size_t row0 = (size_t)bbh * T + ch * 128;
        *(LAS u32x4*)(STb + sdv * SST + sdk0 * 2) = sa; *(LAS u32x4*)(STb + sdv * SST + sdk0 * 2 + 16) = sb;
        VM_WAIT(); __syncthreads();
        u32x2 gwv[2][4];
#pragma unroll
        for (int dd = 0; dd < 2; ++dd)
#pragma unroll
            for (int g = 0; g < 4; ++g) gwv[dd][g] = *(const u32x2*)(proj + (row0 + i) * NPROJ + C_RG + hh * 128 + 32 * (2 * wp + dd) + 8 * g + 4 * hi5);
        const float ei = ex2((float)i * lg2);
        {
#pragma unroll 1
            for (int jj = 0; jj < 2; ++jj) { const int jt = 2 * wp + jj; f32x16 acc;
#pragma unroll
                for (int r = 0; r < 16; ++r) acc[r] = 0.f;
#pragma unroll
                for (int s = 0; s < 4; ++s) acc = MFMA32(frag_sw(Ks, 32 * jt + lr, 2 * s + hi5), frag_sw(Qs, 32 * wq + lr, 2 * s + hi5), acc);
#pragma unroll
                for (int g = 0; g < 4; ++g) { float pv[4];
#pragma unroll
                    for (int e = 0; e < 4; ++e) { const int j = 32 * jt + 8 * g + 4 * hi5 + e; pv[e] = (i >= j) ? acc[4 * g + e] * ei * ex2(-(float)j * lg2) : 0.f; }
                    u32x2 w; w.x = pk2(pv[0], pv[1]); w.y = pk2(pv[2], pv[3]); *(LAS u32x2*)(Ps + i * PST + (32 * jt + 8 * g + 4 * hi5) * 2) = w; } }
        }
        __syncthreads();
        f32x16 o[2];
        {
            const float qd = ex2((float)(i + 1) * lg2);
#pragma unroll
            for (int dd = 0; dd < 2; ++dd) { const int dt = 2 * wp + dd; f32x16 a1, a2;
#pragma unroll
                for (int r = 0; r < 16; ++r) { a1[r] = 0.f; a2[r] = 0.f; }
#pragma unroll 2
                for (int s = 0; s < 8; ++s) a1 = MFMA32(frag128(VT, 32 * dt + lr, 2 * s + hi5), lds_frag(Ps + (32 * wq + lr) * PST + (16 * s + 8 * hi5) * 2), a1);
#pragma unroll
                for (int s = 0; s < 4; ++s) a2 = MFMA32(lds_frag(STb + (32 * dt + lr) * SST + (16 * s + 8 * hi5) * 2), frag_sw(Qs, 32 * wq + lr, 2 * s + hi5), a2);
#pragma unroll
                for (int r = 0; r < 16; ++r) o[dd][r] = a1[r] + qd * a2[r]; }
            float sq = 0.f;
#pragma unroll
            for (int r = 0; r < 16; ++r) sq += o[0][r] * o[0][r] + o[1][r] * o[1][r];
            sq = swap32_sum(sq);
            if (hi5 == 0) SSQ[i * 2 + wp] = sq;
        }
        __syncthreads();
        if (item + 1 < hi) ret_out_stage(C, (item + 1) % (BG * 8), (item + 1) / (BG * 8), Qs, Ks, VT, sa, sb);
        {
            const float rn = __builtin_amdgcn_rsqf((SSQ[i * 2] + SSQ[i * 2 + 1]) * (1.f / 128.f) + RMS_EPS);
#pragma unroll
            for (int dd = 0; dd < 2; ++dd)
#pragma unroll
                for (int g = 0; g < 4; ++g) { const int dv = 32 * (2 * wp + dd) + 8 * g + 4 * hi5;
                    const u32x2 gw = gwv[dd][g];
                    u32x2 w; w.x = pkh2(siluf_(lo_f(gw.x)) * o[dd][4 * g] * rn, siluf_(hi_f(gw.x)) * o[dd][4 * g + 1] * rn); w.y = pkh2(siluf_(lo_f(gw.y)) * o[dd][4 * g + 2] * rn, siluf_(hi_f(gw.y)) * o[dd][4 * g + 3] * rn);
                    *(u32x2*)(yret + (row0 + i) * 1024 + hh * 128 + dv) = w; }
        }
    }
}

constexpr float DSA_QSCALE = 0.125f * 1.4426950408889634f;
DI void dsa_prep(const Ctx& C, const float* pcos, const float* psin) {
    unsigned char* const ws = kargs()->ws; bf16* proj = (bf16*)(ws + WS_PROJ); bf16* vT = (bf16*)(ws + WS_VT);
    const int gt = C.blk * 512 + C.tid, NT = C.G * 512;
    for (int task = gt; task < MG * 14; task += NT) {
        const int tok = task / 14, hb = task % 14, pos = tok % T;
        const int col = hb < 8 ? C_DQ + 64 * hb : hb == 8 ? C_DK : hb < 13 ? C_DQI + 64 * (hb - 9) : C_DKI;
        bf16* p = proj + (size_t)tok * NPROJ + col; const bool isq = hb < 8; const float sc = isq ? DSA_QSCALE : 1.f;
        const u32x4 xa = *(const u32x4*)p, xb = *(const u32x4*)(p + 8);
        const f32x4 c0 = *(const f32x4*)(pcos + (size_t)pos * 8), c1 = *(const f32x4*)(pcos + (size_t)pos * 8 + 4), s0 = *(const f32x4*)(psin + (size_t)pos * 8), s1 = *(const f32x4*)(psin + (size_t)pos * 8 + 4);
        const float cc[8] = {c0[0], c0[1], c0[2], c0[3], c1[0], c1[1], c1[2], c1[3]}; const float sn[8] = {s0[0], s0[1], s0[2], s0[3], s1[0], s1[1], s1[2], s1[3]};
        u32x4 oa, ob;
#pragma unroll
        for (int e = 0; e < 4; ++e) { const float a0 = lo_f(xa[e]), a1 = hi_f(xa[e]), b0 = lo_f(xb[e]), b1 = hi_f(xb[e]);
            oa[e] = pk2((a0 * cc[2 * e] - b0 * sn[2 * e]) * sc, (a1 * cc[2 * e + 1] - b1 * sn[2 * e + 1]) * sc); ob[e] = pk2((a0 * sn[2 * e] + b0 * cc[2 * e]) * sc, (a1 * sn[2 * e + 1] + b1 * cc[2 * e + 1]) * sc); }
        *(u32x4*)p = oa; *(u32x4*)(p + 8) = ob;
        if (isq) {
#pragma unroll
            for (int c = 2; c < 8; ++c) { u32x4 x = *(const u32x4*)(p + 8 * c);
#pragma unroll
                for (int e = 0; e < 4; ++e) x[e] = pk2(lo_f(x[e]) * sc, hi_f(x[e]) * sc);
                *(u32x4*)(p + 8 * c) = x; } }
    }
    const int gw = C.blk * 8 + C.wave, NGW = C.G * 8;
    for (int wt = gw; wt < (MG / 64) * 8; wt += NGW) { const int tok = (wt >> 3) * 64 + C.lane, dc = wt & 7, bb = tok / T, pos = tok % T;
        const u32x4 xv = *(const u32x4*)(proj + (size_t)tok * NPROJ + C_DV + 8 * dc);
#pragma unroll
        for (int e = 0; e < 4; ++e) { vT[((size_t)bb * 64 + 8 * dc + 2 * e) * T + pos] = (bf16)(xv[e] & 0xffffu); vT[((size_t)bb * 64 + 8 * dc + 2 * e + 1) * T + pos] = (bf16)(xv[e] >> 16); } }
}
DI void dsa_select_item(const Ctx& C, int item) {
    unsigned char* const ws = kargs()->ws;
    const bf16* proj = (const bf16*)(ws + WS_PROJ); unsigned* maskg = (unsigned*)(ws + WS_MASK);
    const int q0 = item * 16, bb = q0 / T, t0 = q0 % T;
    constexpr int SCS = 2083;
    LAS float* SC = (LAS float*)C.lds;
    const int fr = C.lane & 15, fq = C.lane >> 4;
    bf16x8 bq[4][2]; float wq[4];
#pragma unroll
    for (int hh = 0; hh < 4; ++hh) {
#pragma unroll
        for (int s = 0; s < 2; ++s) bq[hh][s] = *(const bf16x8*)(proj + (size_t)(q0 + fr) * NPROJ + C_DQI + 64 * hh + 32 * s + 8 * fq);
        wq[hh] = bf2f(proj[(size_t)(q0 + fr) * NPROJ + C_DWI + hh]) * 0.0625f;
    }
    const int ntile = (t0 + 15) / 16 + 1;
    const bf16* kbase = proj + ((size_t)bb * T + fr) * NPROJ + C_DKI + 8 * fq;
    __syncthreads();
    REPX(40)
#pragma unroll 1
    for (int i0 = C.wave; i0 < ntile; i0 += 32) {
        bf16x8 a[4][2];
#pragma unroll
        for (int u = 0; u < 4; ++u) { const int i = i0 + 8 * u; const int ic = i < ntile ? i : i0;
            a[u][0] = *(const bf16x8*)(kbase + (size_t)ic * 16 * NPROJ); a[u][1] = *(const bf16x8*)(kbase + (size_t)ic * 16 * NPROJ + 32); }
#pragma unroll
        for (int u = 0; u < 4; ++u) { const int i = i0 + 8 * u;
            if (i < ntile) {
                f32x4 sc = {0.f, 0.f, 0.f, 0.f};
#pragma unroll
                for (int hh = 0; hh < 4; ++hh) { f32x4 acc = {0.f, 0.f, 0.f, 0.f}; acc = MFMA16(a[u][0], bq[hh][0], acc); acc = MFMA16(a[u][1], bq[hh][1], acc);
#pragma unroll
                    for (int j = 0; j < 4; ++j) sc[j] += wq[hh] * fmaxf(acc[j], 0.f); }
                const int key0 = 16 * i + 4 * fq;
#pragma unroll
                for (int j = 0; j < 4; ++j) { sc[j] += 0.f; if (key0 + j > t0 + fr) sc[j] = NEG_BIG; SC[fr * SCS + ((key0 + j) & 31) * 65 + (key0 >> 5)] = sc[j]; }
            } }
    }
    __syncthreads();
    LAS unsigned* hist = (LAS unsigned*)(C.lds + 16 * SCS * 4) + C.wave * 320;
    const unsigned dummy = 256u + (unsigned)C.lane;
#pragma unroll 1
    for (int qq = 0; qq < 2; ++qq) {
        const int q = C.wave + 8 * qq, p = t0 + q;
        unsigned* mrow = maskg + (size_t)(q0 + q) * 64;
        const int pl = p - 32 * C.lane;
        if ((p + 1) <= 256) { mrow[C.lane] = pl >= 31 ? 0xffffffffu : (pl < 0 ? 0u : ((2u << pl) - 1u)); continue; }
        unsigned u[32];
#pragma unroll
        for (int j = 0; j < 32; ++j) { unsigned x = 0u;
            if (j <= pl) { x = __float_as_uint(SC[q * SCS + j * 65 + C.lane]); x = (x & 0x80000000u) ? ~x : (x | 0x80000000u); }
            u[j] = x; }
        unsigned prefix = 0u; int remaining = 256, cnt_eq = 0;
#pragma unroll 1
        for (int pass = 0; pass < 4; ++pass) {
            const int shift = 24 - 8 * pass; const unsigned himask = pass == 0 ? 0u : (0xffffffffu << (shift + 8));
            *(LAS u32x4*)(hist + 4 * C.lane) = (u32x4){0u, 0u, 0u, 0u};
            LDS_WAIT();
            if (pass < 2) {
#pragma unroll
                for (int j = 0; j < 32; ++j) { const bool cand = (u[j] != 0u) & (((u[j] ^ prefix) & himask) == 0u);
                    __hip_atomic_fetch_add(hist + (cand ? ((u[j] >> shift) & 255u) : dummy), 1u, __ATOMIC_RELAXED, __HIP_MEMORY_SCOPE_WORKGROUP); }
            } else {
#pragma unroll
                for (int j = 0; j < 32; ++j) { if ((u[j] != 0u) & (((u[j] ^ prefix) & himask) == 0u)) __hip_atomic_fetch_add(hist + ((u[j] >> shift) & 255u), 1u, __ATOMIC_RELAXED, __HIP_MEMORY_SCOPE_WORKGROUP); }
            }
            LDS_WAIT();
            const u32x4 cn = *(const LAS u32x4*)(hist + 4 * C.lane);
            const int tl = (int)(cn[0] + cn[1] + cn[2] + cn[3]);
            int v = tl;
            v += dppi<0x111>(v); v += dppi<0x112>(v); v += dppi<0x114>(v); v += dppi<0x118>(v);
            const int r0 = __builtin_amdgcn_readlane(v, 15), r1 = __builtin_amdgcn_readlane(v, 31), r2 = __builtin_amdgcn_readlane(v, 47), r3 = __builtin_amdgcn_readlane(v, 63);
            const int row = C.lane >> 4; v += (row >= 1 ? r0 : 0) + (row >= 2 ? r1 : 0) + (row >= 3 ? r2 : 0);
            const int total = r0 + r1 + r2 + r3;
            const int suf = total - v + tl;
            const unsigned long long bm = __ballot(suf >= remaining);
            const int L = 63 - __builtin_clzll(bm);
            const int above = __builtin_amdgcn_readlane(suf - tl, L);
            const int c3 = __builtin_amdgcn_readlane((int)cn[3], L), c2 = __builtin_amdgcn_readlane((int)cn[2], L), c1 = __builtin_amdgcn_readlane((int)cn[1], L), c0 = __builtin_amdgcn_readlane((int)cn[0], L);
            int acc = above, dig;
            if (acc + c3 >= remaining) { dig = 3; cnt_eq = c3; } else { acc += c3; if (acc + c2 >= remaining) { dig = 2; cnt_eq = c2; } else { acc += c2; if (acc + c1 >= remaining) { dig = 1; cnt_eq = c1; } else { acc += c1; dig = 0; cnt_eq = c0; } } }
            remaining -= acc; prefix |= (unsigned)(4 * L + dig) << shift;
        }
        const unsigned thr = prefix; const int need = remaining;
        unsigned bits = 0u; unsigned one = 1u; asm volatile("" : "+v"(one));
        if (need >= cnt_eq) {
#pragma unroll
            for (int j = 0; j < 32; ++j) bits |= (u[j] >= thr ? one : 0u) << j;
        } else {
            int tc = 0;
#pragma unroll
            for (int j = 0; j < 32; ++j) tc += (u[j] == thr) ? 1 : 0;
            int v = tc; v += dppi<0x111>(v); v += dppi<0x112>(v); v += dppi<0x114>(v); v += dppi<0x118>(v);
            const int r0 = __builtin_amdgcn_readlane(v, 15), r1 = __builtin_amdgcn_readlane(v, 31), r2 = __builtin_amdgcn_readlane(v, 47);
            const int row = C.lane >> 4; v += (row >= 1 ? r0 : 0) + (row >= 2 ? r1 : 0) + (row >= 3 ? r2 : 0);
            int rank = v - tc;
#pragma unroll
            for (int j = 0; j < 32; ++j) { const bool tie = u[j] == thr; bits |= ((u[j] > thr || (tie && rank < need)) ? one : 0u) << j; rank += tie ? 1 : 0; }
        }
        mrow[C.lane] = bits;
    }
}
DI void dsa_attn_item(const Ctx& C, int bbh, int qt) {
    unsigned char* const ws = kargs()->ws;
    const bf16* proj = (const bf16*)(ws + WS_PROJ); const unsigned* maskg = (const unsigned*)(ws + WS_MASK); bf16* ydsa = (bf16*)(ws + WS_YDR); const bf16* vT = (const bf16*)(ws + WS_VT);
    constexpr int PST = 144;
    ldsp KR = C.lds, VR = C.lds + 16384, PW = C.lds + 32768 + C.wave * (32 * PST);
    const int t0 = qt * 32; const size_t qrow0 = (size_t)bbh * T + t0; const int lr = C.lane & 31, hi = C.lane >> 5, hh = C.wave;
    bf16x8 bq[4];
#pragma unroll
    for (int s = 0; s < 4; ++s) bq[s] = *(const bf16x8*)(proj + (qrow0 + lr) * NPROJ + C_DQ + 64 * hh + 16 * s + 8 * hi);
    f32x16 o0, o1;
#pragma unroll
    for (int r = 0; r < 16; ++r) { o0[r] = 0.f; o1[r] = 0.f; }
    float mrun = -1e20f, lrun = 0.f;
    const unsigned* mrow = maskg + (qrow0 + lr) * 64;
    const int nkt = (t0 + 31) / 64 + 1;
    const bf16* kbase = proj + (size_t)bbh * T * NPROJ + C_DK; const bf16* vbase = vT + (size_t)bbh * 64 * T;
    __syncthreads();
    dma_tile64<64>(KR, kbase, NPROJ, C.wave, C.lane); dma_tile64<64>(VR, vbase, T, C.wave, C.lane);
    unsigned mw0 = mrow[0], mw1 = mrow[1];
    for (int kt = 0; kt < nkt; ++kt) {
        VM_WAIT(); __syncthreads();
        const unsigned cw0 = mw0, cw1 = mw1;
        if (kt + 1 < nkt) { mw0 = mrow[2 * kt + 2]; mw1 = mrow[2 * kt + 3];
            dma_tile64<64>(KR + ((kt + 1) & 1) * 8192, kbase + (size_t)(kt + 1) * 64 * NPROJ, NPROJ, C.wave, C.lane); dma_tile64<64>(VR + ((kt + 1) & 1) * 8192, vbase + (kt + 1) * 64, T, C.wave, C.lane); }
        ldsp KT = KR + (kt & 1) * 8192, VT = VR + (kt & 1) * 8192;
        f32x16 p0, p1;
#pragma unroll
        for (int r = 0; r < 16; ++r) { p0[r] = 0.f; p1[r] = 0.f; }
#pragma unroll
        for (int s = 0; s < 4; ++s) { p0 = MFMA32(frag_sw(KT, lr, 2 * s + hi), bq[s], p0); p1 = MFMA32(frag_sw(KT, 32 + lr, 2 * s + hi), bq[s], p1); }
        const unsigned s0 = cw0 >> (4 * hi), s1 = cw1 >> (4 * hi); float mx = -1e20f;
#pragma unroll
        for (int r = 0; r < 16; ++r) { const unsigned bp = (unsigned)((r & 3) + 8 * (r >> 2)); const unsigned m0 = (unsigned)__builtin_amdgcn_sbfe((int)s0, bp, 1u), m1 = (unsigned)__builtin_amdgcn_sbfe((int)s1, bp, 1u);
            p0[r] = __uint_as_float((__float_as_uint(p0[r]) & m0) | (0xf149f2cau & ~m0)); p1[r] = __uint_as_float((__float_as_uint(p1[r]) & m1) | (0xf149f2cau & ~m1));
            mx = fmaxf(mx, fmaxf(p0[r], p1[r])); }
        mx = swap32_max(mx);
        if (!__all(mx - mrun <= 8.f)) { const float mnew = fmaxf(mrun, mx); const float alpha = __builtin_amdgcn_exp2f(mrun - mnew); mrun = mnew; lrun *= alpha;
#pragma unroll
            for (int r = 0; r < 16; ++r) { o0[r] *= alpha; o1[r] *= alpha; } }
        float ps = 0.f;
#pragma unroll
        for (int r = 0; r < 16; ++r) { p0[r] = __builtin_amdgcn_exp2f(p0[r] - mrun); p1[r] = __builtin_amdgcn_exp2f(p1[r] - mrun); ps += p0[r] + p1[r]; }
        lrun += ps;
#pragma unroll
        for (int g = 0; g < 4; ++g) { u32x2 w0, w1; w0.x = pk2(p0[4 * g], p0[4 * g + 1]); w0.y = pk2(p0[4 * g + 2], p0[4 * g + 3]); w1.x = pk2(p1[4 * g], p1[4 * g + 1]); w1.y = pk2(p1[4 * g + 2], p1[4 * g + 3]);
            *(LAS u32x2*)(PW + lr * PST + (8 * g + 4 * hi) * 2) = w0; *(LAS u32x2*)(PW + lr * PST + (32 + 8 * g + 4 * hi) * 2) = w1; }
        LDS_WAIT();
#pragma unroll
        for (int s = 0; s < 4; ++s) { const bf16x8 pf = lds_frag(PW + lr * PST + (16 * s + 8 * hi) * 2);
            o0 = MFMA32(frag_sw(VT, lr, 2 * s + hi), pf, o0); o1 = MFMA32(frag_sw(VT, 32 + lr, 2 * s + hi), pf, o1); }
    }
    const float linv = __builtin_amdgcn_rcpf(swap32_sum(lrun));
    bf16* yo = ydsa + (qrow0 + lr) * 1024 + hh * 64;
#pragma unroll
    for (int g = 0; g < 4; ++g) { u32x2 w0, w1; w0.x = pkh2(o0[4 * g] * linv, o0[4 * g + 1] * linv); w0.y = pkh2(o0[4 * g + 2] * linv, o0[4 * g + 3] * linv);
        w1.x = pkh2(o1[4 * g] * linv, o1[4 * g + 1] * linv); w1.y = pkh2(o1[4 * g + 2] * linv, o1[4 * g + 3] * linv);
        *(u32x2*)(yo + 8 * g + 4 * hi) = w0; *(u32x2*)(yo + 32 + 8 * g + 4 * hi) = w1; }
}

DI void final_norm(const Ctx& C, const float* gain, const float* ss) {
    const kargp ap = kargs(); float* const out = ap->out; const bf16* x16 = (const bf16*)(ap->ws + WS_XB);
    const int gw = C.blk * 8 + C.wave, NGW = C.G * 8;
    f32x4 gv[4];
#pragma unroll
    for (int j = 0; j < 4; ++j) gv[j] = *((const f32x4*)gain + C.lane + 64 * j);
    for (int m0 = gw; m0 < M; m0 += 4 * NGW) {
        u32x2 v[4][4]; float rs[4];
#pragma unroll
        for (int r = 0; r < 4; ++r) { const int m = m0 + r * NGW; const int mc = m < M ? m : m0; rs[r] = pg8::rstd_of(ss + (size_t)mc * 16); const u32x2* xr = (const u32x2*)(x16 + (size_t)mc * D) + C.lane;
#pragma unroll
            for (int j = 0; j < 4; ++j) v[r][j] = xr[64 * j]; }
#pragma unroll
        for (int r = 0; r < 4; ++r) { const int m = m0 + r * NGW; if (m < M) { f32x4* xo = (f32x4*)(out + (size_t)m * D) + C.lane;
#pragma unroll
            for (int j = 0; j < 4; ++j) { const f32x4 x = {hlo_f(v[r][j].x), hhi_f(v[r][j].x), hlo_f(v[r][j].y), hhi_f(v[r][j].y)}; xo[64 * j] = x * rs[r] * gv[j]; } } }
    }
}

#ifndef PH_MASK
#define PH_MASK 0xFFFF
#endif
#define PH(b) if constexpr ((PH_MASK >> (b)) & 1)
#ifndef DUP_PHASE
#define DUP_PHASE -1
#endif
#define REP(k) for (int rep = 0; rep < ((DUP_PHASE == (k)) ? 2 : 1); ++rep)
__global__ void __launch_bounds__(512, 2) fwd_kernel(Args a_unused) {
    extern __shared__ __attribute__((aligned(16))) unsigned char lds_raw[];
    Ctx C; C.lds = (ldsp)lds_raw; C.tid = threadIdx.x; C.lane = C.tid & 63; C.wave = __builtin_amdgcn_readfirstlane(C.tid >> 6); C.G = gridDim.x; C.blk = blockIdx.x;
    volatile LAS unsigned* MISC = (volatile LAS unsigned*)(C.lds + MISC_OFF);
    if (C.tid < 64) MISC[C.tid] = 0u;
    __syncthreads();
    XcdBarrier bar = xcd_barrier_post((unsigned*)(kargs()->ws + WS_CTL) + CW_BAR, MISC + 8);
#define GRID_BAR() xcd_barrier(bar)
#define WSP() (kargs()->ws)
#define SSP(ws_, idx) ((float*)((ws_) + WS_SS) + (size_t)(idx) * (SS_BYTES / 4))
#define TABP(ws_, off) ((const float*)((ws_) + WS_TAB) + (off) / 4)

    REP(0) { PH(0) { const Ctx Cp = fresh(C); p0_prologue(Cp); }
    GRID_BAR(); }

#pragma unroll 1
    for (int hl = 0; hl < 2 * DEPTH; ++hl) {
        const int l = hl >> 1; const bool isB = hl & 1;
        REP(1) { PH(1) { const Ctx Cp = fresh(C);
            unsigned char* const ws = WSP(); const bf16* wl = (const bf16*)(ws + WS_W + (size_t)l * W_LAYER_BYTES);
            pg8::Gemm g{(const bf16*)(ws + WS_XB), wl + (isB ? WO_FFB_IN : WO_FFA_IN), M, 2 * DFF, D}; pg8::StaticOrder S; S.init(M, 2 * DFF, Cp.G, Cp.blk);
            pg8::EpiSwiglu E{(bf16*)(ws + WS_ACT), SSP(ws, isB ? 3 * l + 2 : 3 * l)};
#ifdef PROBE_NULL_EPI
            if (rep) { pg8::EpiNull EN{(float*)(ws + WS_CTL) + 8192}; pg8::gemm_phase<pg8::EpiNull, pg8::StaticOrder, PG8_ALIGN, PG8_SP2, false, PROBE_NULL_EPI - 1>(Cp.lds, g, S, EN, Cp.tid); } else
#endif
            pg8::gemm_phase<pg8::EpiSwiglu, pg8::StaticOrder, PG8_ALIGN, PG8_SP2>(Cp.lds, g, S, E, Cp.tid);
        }
        GRID_BAR(); }
        REP(2) { PH(2) { const Ctx Cp = fresh(C);
            const kargp ap = kargs(); unsigned char* const ws = ap->ws; float* const out = ap->out; const bf16* wl = (const bf16*)(ws + WS_W + (size_t)l * W_LAYER_BYTES);
            pg8::Gemm g{(const bf16*)(ws + WS_ACT), wl + (isB ? WO_FFB_OUT : WO_FFA_OUT), M, D, DFF}; pg8::StaticOrder S; S.init(M, D, Cp.G, Cp.blk);
            pg8::EpiResid E{(bf16*)(ws + WS_XB), SSP(ws, isB ? 3 * l + 3 : 3 * l + 1), rep ? 0.f : 0.5f, 0};
            pg8::gemm_phase<pg8::EpiResid, pg8::StaticOrder, PG8_ALIGN, PG8_SP2, true>(Cp.lds, g, S, E, Cp.tid);
        }
        GRID_BAR(); }
        if (isB) continue;
#pragma unroll 1
        for (int st = 0; st <= NG; ++st) {
            if (st >= 1) {
            const int grp = st - 1; const size_t grow = (size_t)grp * MG;
            REP(30) {
                REP(13) PH(6) { const Ctx Cp = fresh(C); const kargp ap = kargs(); const bf16* wl = (const bf16*)(ap->ws + WS_W + (size_t)l * W_LAYER_BYTES);
                    RwkvP P{ap->in[I_MU] + l * 1792, ap->in[I_W0] + l * 512, ap->in[I_A0] + l * 512, ap->in[I_KK] + l * 512, ap->in[I_KA] + l * 512, ap->in[I_RK] + l * 512, wl + WO_W2T, wl + WO_A2T, wl + WO_G2T};
                    for (int it = Cp.blk; it < NCHAIN * NRCH; it += Cp.G) rwkv_pre_item(Cp, P, it); }
                REP(7) PH(7) { const Ctx Cp = fresh(C); unsigned char* const ws = WSP(); for (int it = Cp.blk; it < BG * 8 * 15; it += Cp.G) ret_state_item(Cp, it / 15, it % 15, TABP(ws, TAB_RCOS), TABP(ws, TAB_RSIN)); }
                PH(5) if (rep == 0) { const Ctx Cp = fresh(C); unsigned char* const ws = WSP(); dsa_prep(Cp, TABP(ws, TAB_PCOS), TABP(ws, TAB_PSIN)); }
                REP(19) PH(7) { const Ctx Cp = fresh(C); unsigned char* const ws = WSP(); ret_prep(Cp, TABP(ws, TAB_RCOS), TABP(ws, TAB_RSIN)); }
            GRID_BAR(); }
            REP(31) {
                PH(7) { const Ctx Cp = fresh(C); ret_scan(Cp); }
                if (C.blk < NCHAIN) { REP(16) PH(6) { const Ctx Cp = fresh(C); rwkv_state_chain(Cp, Cp.blk); } }
                REP(14) PH(8) { const Ctx Cp = fresh(C);
                    constexpr int NU = MG / 16;
                    unsigned* const ctr = (unsigned*)(kargs()->ws + WS_CTL) + CW_QUEUE + (((l * NG + grp) * 2 + 0) * 2 + rep) * 64;
                    volatile LAS unsigned* QS = (volatile LAS unsigned*)(Cp.lds + MISC_OFF) + 16;
                    if (Cp.tid == 0) QS[0] = __hip_atomic_fetch_add(ctr, 1u, __ATOMIC_RELAXED, __HIP_MEMORY_SCOPE_AGENT);
                    __syncthreads();
                    unsigned it = QS[0]; int slot = 1;
                    while (it < (unsigned)NU) {
                        unsigned nxt = 0u; if (Cp.tid == 0) nxt = __hip_atomic_fetch_add(ctr, 1u, __ATOMIC_RELAXED, __HIP_MEMORY_SCOPE_AGENT);
                        { REPX(20) dsa_select_item(Cp, (int)(it & 3u) * (T / 16) + (T / 16 - 1) - (int)(it >> 2)); }
                        if (Cp.tid == 0) QS[slot] = nxt;
                        __syncthreads();
                        it = QS[slot]; slot ^= 1; } }
            GRID_BAR(); }
            REP(32) {
                REP(15) PH(8) { const Ctx Cp = fresh(C); const int idx = Cp.blk; if (idx < BG * 64) dsa_attn_item(Cp, idx & 3, 63 - (idx >> 2)); }
                REP(9) PH(9) { const Ctx Cp = fresh(C); const kargp ap = kargs(); const float* lnw = ap->in[I_LNW] + l * 512; const float* lnb = ap->in[I_LNB] + l * 512;
                    const int lo = (Cp.blk * Cp.blk + 63) / 64, hi = ((Cp.blk + 1) * (Cp.blk + 1) + 63) / 64;
                    { REPX(22) rwkv_out_items(Cp, lo, hi < NCHAIN * NRCH ? hi : NCHAIN * NRCH, lnw, lnb); }
                    { const int rlo = (lo + 1) / 2, rhi = (hi + 1) / 2; REPX(21) ret_out_items(Cp, rlo, rhi < BG * 8 * 16 ? rhi : BG * 8 * 16); } }
            GRID_BAR(); }
            REP(10) { PH(10) {
                const Ctx Cp = fresh(C); unsigned char* const ws = WSP(); const bf16* wl = (const bf16*)(ws + WS_W + (size_t)l * W_LAYER_BYTES);
                pg8::MergeSched S{(const char*)(ws + WS_YRET), (const char*)(ws + WS_YDR), (const char*)(wl + WO_PRET), (const char*)(wl + WO_PDR), (MG / 256) * (D / 128), Cp.blk, D / 128};
                pg8::EpiMerge3 E{}; E.proj = (const bf16*)(ws + WS_PROJ); E.merged = (bf16*)(ws + WS_MERGED);
                pg8::gemm_nhalf_phase<pg8::EpiMerge3, pg8::MergeSched, 1024>(Cp.lds, S, E, Cp.tid);
            }
            GRID_BAR(); }
            REP(11) { PH(11) {
                if (C.blk >= (C.G >> 1)) { const Ctx Cp = fresh(C);
                unsigned char* const ws = WSP(); const bf16* wl = (const bf16*)(ws + WS_W + (size_t)l * W_LAYER_BYTES);
                pg8::Gemm g{(const bf16*)(ws + WS_MERGED), wl + WO_WOUT, MG, D, D}; pg8::StaticOrder S; S.init(MG, D, Cp.G >> 1, Cp.blk - (Cp.G >> 1));
                pg8::EpiResid E{(bf16*)(ws + WS_XB), SSP(ws, 3 * l + 2), rep ? 0.f : 1.0f, (int)grow};
                pg8::gemm_phase<pg8::EpiResid, pg8::StaticOrder, PG8_ALIGN, PG8_SP2>(Cp.lds, g, S, E, Cp.tid); }
            }
            }
            }
            if (st < NG) {
            const size_t grow = (size_t)st * MG;
            REP(3) { PH(3) {
                const Ctx Cp = fresh(C);
                unsigned char* const ws = WSP(); const bf16* wl = (const bf16*)(ws + WS_W + (size_t)l * W_LAYER_BYTES);
                pg8::Gemm g{(const bf16*)(ws + WS_XB) + grow * D, wl + WO_WIN, MG, NPROJ, D}; pg8::StaticOrder S; S.init(MG, NPROJ, Cp.G, Cp.blk);
                pg8::EpiProj E{(bf16*)(ws + WS_PROJ), SSP(ws, 3 * l + 1) + grow * 16};
                pg8::gemm_phase<pg8::EpiProj, pg8::StaticOrder, PG8_ALIGN, PG8_SP2>(Cp.lds, g, S, E, Cp.tid);
            }
            }
            }
            GRID_BAR();
        }
    }
    PH(12) { const Ctx Cp = fresh(C); const kargp ap = kargs(); final_norm(Cp, ap->in[I_NORM_FINAL], SSP(ap->ws, 6)); }
}

extern "C" void kernel_launch(void* const* d_in, const int* in_sizes, int n_in, void* d_out, int out_size, void* d_ws, size_t ws_size, hipStream_t stream) {
    static int grid = 0;
    if (grid == 0) {
        if (n_in != 25 || out_size != M * D || ws_size < WS_END || ws_size < WS_ACT + (size_t)M * DFF * 2) { fprintf(stderr, "kernel_launch: unexpected problem (n_in %d out %d ws %zu)\n", n_in, out_size, ws_size); grid = -1; return; }
        int dev = 0, cus = 0, per_cu = 0;
        if (hipGetDevice(&dev) != hipSuccess || hipDeviceGetAttribute(&cus, hipDeviceAttributeMultiprocessorCount, dev) != hipSuccess) { grid = -1; return; }
        if (hipFuncSetAttribute((const void*)fwd_kernel, hipFuncAttributeMaxDynamicSharedMemorySize, LDS_BYTES) != hipSuccess) { fprintf(stderr, "kernel_launch: hipFuncSetAttribute failed\n"); grid = -1; return; }
        if (hipOccupancyMaxActiveBlocksPerMultiprocessor(&per_cu, (const void*)fwd_kernel, 512, LDS_BYTES) != hipSuccess || per_cu < 1) fprintf(stderr, "kernel_launch: occupancy query reports %d\n", per_cu);
        (void)hipGetLastError();
        grid = cus;
        if (grid != 256) fprintf(stderr, "kernel_launch: %d CUs (built for 256)\n", grid);
    }
    if (grid < 0) return;
    (void)in_sizes;
    hipMemsetAsync((char*)d_ws + WS_CTL, 0, CTL_ZERO_BYTES, stream);
    Args a{};
    for (int i = 0; i < 25; ++i) a.in[i] = (const float*)d_in[i];
    a.out = (float*)d_out; a.ws = (unsigned char*)d_ws;
    for (int i = 0; i < 32; ++i) a.inv_ret[i] = powf(10000.0f, -(float)(2 * i) / 64.0f);
    for (int i = 0; i < 8; ++i) a.inv_rot[i] = powf(500000.0f, -(float)(2 * i) / 16.0f);
    hipLaunchKernelGGL(fwd_kernel, dim3(grid), dim3(512), LDS_BYTES, stream, a);
}
```

```cpp
#include <hip/hip_runtime.h>
#include <cstdio>
#include <cstdint>
#include <cmath>

#define DI __device__ __forceinline__
#define GAS __attribute__((address_space(1)))
#define LAS __attribute__((address_space(3)))
typedef unsigned short bf16;
typedef short bf16x8 __attribute__((ext_vector_type(8)));
typedef float f32x2 __attribute__((ext_vector_type(2)));
typedef float f32x4 __attribute__((ext_vector_type(4)));
typedef float f32x16 __attribute__((ext_vector_type(16)));
typedef unsigned u32x2 __attribute__((ext_vector_type(2)));
typedef unsigned u32x4 __attribute__((ext_vector_type(4)));
typedef LAS unsigned char* ldsp;

constexpr int BATCH = 16, T = 2048, D = 1024, M = BATCH * T, DEPTH = 2, DFF = 2816;
constexpr int NG = 4, BG = BATCH / NG, MG = BG * T;
constexpr int NPROJ = 9216;
constexpr int C_RQ = 0, C_RK = 512, C_RV = 1024, C_RG = 2048;
constexpr int C_DQ = 3072, C_DK = 3584, C_DV = 3648, C_DQI = 3712, C_DKI = 3968, C_DWI = 4032;
constexpr int C_RW = 4096;
constexpr int C_GATE = 5888;
constexpr float RMS_EPS = 1e-6f;
constexpr float DSA_QSCALE_C = 0.125f * 1.4426950408889634f;
constexpr float NEG_BIG = -1e30f;

DI float bf2f(unsigned b) { return __uint_as_float(b << 16); }
DI unsigned pk2(float lo, float hi) { typedef __bf16 b2 __attribute__((ext_vector_type(2))); f32x2 v = {lo, hi}; b2 b = __builtin_convertvector(v, b2); return __builtin_bit_cast(unsigned, b); }
DI bf16 f2bf(float f) { return (bf16)(pk2(f, 0.f) & 0xffffu); }
typedef _Float16 half8 __attribute__((ext_vector_type(8)));
DI unsigned pkh2(float lo, float hi) { typedef _Float16 h2 __attribute__((ext_vector_type(2))); f32x2 v = {lo, hi}; h2 h = __builtin_convertvector(v, h2); return __builtin_bit_cast(unsigned, h); }
DI float hlo_f(unsigned w) { typedef _Float16 h2 __attribute__((ext_vector_type(2))); return (float)__builtin_bit_cast(h2, w)[0]; }
DI float hhi_f(unsigned w) { typedef _Float16 h2 __attribute__((ext_vector_type(2))); return (float)__builtin_bit_cast(h2, w)[1]; }
#define GEMM_MFMA16(b, a, c) __builtin_amdgcn_mfma_f32_16x16x32_f16(__builtin_bit_cast(half8, (b)), __builtin_bit_cast(half8, (a)), (c), 0, 0, 0)
DI float lo_f(unsigned w) { return __uint_as_float(w << 16); }
DI float hi_f(unsigned w) { return __uint_as_float(w & 0xffff0000u); }
DI float sigmoidf_(float x) { return __builtin_amdgcn_rcpf(1.f + __expf(-x)); }
DI float siluf_(float x) { return x * sigmoidf_(x); }
DI float ex2(float x) { return __builtin_amdgcn_exp2f(x); }
DI float tanhf_(float x) { return 1.f - 2.f * __builtin_amdgcn_rcpf(1.f + __expf(2.f * x)); }
DI float ret_lg2(int hh) { const float x = ex2(-5.f - (float)hh); return -(x + x * x * (0.5f + x * (0.33333334f + x * 0.25f))) * 1.4426950408889634f; }

template <int CTRL> DI float dppf(float x) { return __builtin_bit_cast(float, __builtin_amdgcn_mov_dpp(__builtin_bit_cast(int, x), CTRL, 0xf, 0xf, true)); }
template <int CTRL> DI int dppi(int x) { return __builtin_amdgcn_mov_dpp(x, CTRL, 0xf, 0xf, true); }
DI float row16_sum(float x) { x += dppf<0xB1>(x); x += dppf<0x4E>(x); x += dppf<0x141>(x); x += dppf<0x128>(x); return x; }
DI int row16_sum(int x) { x += dppi<0xB1>(x); x += dppi<0x4E>(x); x += dppi<0x141>(x); x += dppi<0x128>(x); return x; }
DI float swap16_sum(float x) { auto s = __builtin_amdgcn_permlane16_swap(__float_as_uint(x), __float_as_uint(x), false, false); return __uint_as_float(s[0]) + __uint_as_float(s[1]); }
DI float swap32_sum(float x) { auto s = __builtin_amdgcn_permlane32_swap(__float_as_uint(x), __float_as_uint(x), false, false); return __uint_as_float(s[0]) + __uint_as_float(s[1]); }
DI float swap32_max(float x) { auto s = __builtin_amdgcn_permlane32_swap(__float_as_uint(x), __float_as_uint(x), false, false); return fmaxf(__uint_as_float(s[0]), __uint_as_float(s[1])); }
DI int swap16_sum(int x) { auto s = __builtin_amdgcn_permlane16_swap((unsigned)x, (unsigned)x, false, false); return (int)(s[0] + s[1]); }
DI int swap32_sum(int x) { auto s = __builtin_amdgcn_permlane32_swap((unsigned)x, (unsigned)x, false, false); return (int)(s[0] + s[1]); }
DI float wave_sum(float x) { return swap32_sum(swap16_sum(row16_sum(x))); }
DI unsigned umax_(unsigned a, unsigned b) { return a > b ? a : b; }
DI unsigned wave_umax(unsigned x) { x = umax_(x, (unsigned)dppi<0xB1>((int)x)); x = umax_(x, (unsigned)dppi<0x4E>((int)x)); x = umax_(x, (unsigned)dppi<0x141>((int)x)); x = umax_(x, (unsigned)dppi<0x128>((int)x));
    { auto s = __builtin_amdgcn_permlane16_swap(x, x, false, false); x = umax_(s[0], s[1]); } { auto s = __builtin_amdgcn_permlane32_swap(x, x, false, false); x = umax_(s[0], s[1]); } return x; }
DI int wave_sum(int x) { return swap32_sum(swap16_sum(row16_sum(x))); }
DI float half32_sum(float x) { return swap16_sum(row16_sum(x)); }
DI int crow(int r, int hi) { return (r & 3) + 8 * (r >> 2) + 4 * hi; }
#define MFMA32(a, b, c) __builtin_amdgcn_mfma_f32_32x32x16_bf16((a), (b), (c), 0, 0, 0)
#define MFMA16(a, b, c) __builtin_amdgcn_mfma_f32_16x16x32_bf16((a), (b), (c), 0, 0, 0)
#define LDS_WAIT() asm volatile("s_waitcnt lgkmcnt(0)" ::: "memory")
#define VM_WAIT() asm volatile("s_waitcnt vmcnt(0)" ::: "memory")
DI bf16x8 lds_frag(ldsp p) { return *(const LAS bf16x8*)p; }
DI unsigned offb(unsigned row, unsigned ch) { return 256u * row + 16u * (ch ^ (((row & 3u) << 2) | ((row >> 2) & 3u))); }
template <int ROWS> DI void dma_tile128b(ldsp dst, const bf16* src, size_t src_stride, int wave, int lane) {
#pragma unroll
    for (int g0 = 0; g0 < ROWS / 4; g0 += 8) { const int g = g0 + wave; const int row = g * 4 + (lane >> 4), ch = (lane & 15) ^ (((row & 3) << 2) | ((row >> 2) & 3));
        __builtin_amdgcn_global_load_lds((const unsigned*)(src + (size_t)row * src_stride + 8 * ch), (LAS unsigned*)(dst + g * 1024), 16, 0, 0); }
}
DI unsigned tr_addr0(unsigned lane, unsigned c, unsigned t) { const unsigned h = lane >> 5, blk = (lane >> 4) & 1u, q = (lane & 15u) >> 2, pp = lane & 3u; return offb(8u * h + 4u * t + q, 4u * c + 2u * blk + (pp >> 1)) + 8u * (pp & 1u); }
DI void tr_frags8(unsigned a0, unsigned a1, bf16x8 (&f)[8]) {
    u32x2 r0, r1, r2, r3, r4, r5, r6, r7, r8, r9, r10, r11, r12, r13, r14, r15;
    asm volatile("ds_read_b64_tr_b16 %0, %16\n\tds_read_b64_tr_b16 %1, %17\n\t"
                 "ds_read_b64_tr_b16 %2, %16 offset:4096\n\tds_read_b64_tr_b16 %3, %17 offset:4096\n\t"
                 "ds_read_b64_tr_b16 %4, %16 offset:8192\n\tds_read_b64_tr_b16 %5, %17 offset:8192\n\t"
                 "ds_read_b64_tr_b16 %6, %16 offset:12288\n\tds_read_b64_tr_b16 %7, %17 offset:12288\n\t"
                 "ds_read_b64_tr_b16 %8, %16 offset:16384\n\tds_read_b64_tr_b16 %9, %17 offset:16384\n\t"
                 "ds_read_b64_tr_b16 %10, %16 offset:20480\n\tds_read_b64_tr_b16 %11, %17 offset:20480\n\t"
                 "ds_read_b64_tr_b16 %12, %16 offset:24576\n\tds_read_b64_tr_b16 %13, %17 offset:24576\n\t"
                 "ds_read_b64_tr_b16 %14, %16 offset:28672\n\tds_read_b64_tr_b16 %15, %17 offset:28672\n\t"
                 "s_waitcnt lgkmcnt(0)"
                 : "=&v"(r0), "=&v"(r1), "=&v"(r2), "=&v"(r3), "=&v"(r4), "=&v"(r5), "=&v"(r6), "=&v"(r7), "=&v"(r8), "=&v"(r9), "=&v"(r10), "=&v"(r11), "=&v"(r12), "=&v"(r13), "=&v"(r14), "=&v"(r15)
                 : "v"(a0), "v"(a1) : "memory");
#define TR_PACK(k_, lo_, hi_) f[k_] = __builtin_bit_cast(bf16x8, (u32x4){lo_.x, lo_.y, hi_.x, hi_.y})
    TR_PACK(0, r0, r1); TR_PACK(1, r2, r3); TR_PACK(2, r4, r5); TR_PACK(3, r6, r7); TR_PACK(4, r8, r9); TR_PACK(5, r10, r11); TR_PACK(6, r12, r13); TR_PACK(7, r14, r15);
#undef TR_PACK
}

namespace pg8 {
#define PG8_LAS __attribute__((address_space(3)))
typedef unsigned short bf16_t;
constexpr int BM = 256, BK = 64, HALF = 128, HTB = HALF * BK * 2, STAGE_BYTES = 8 * HTB, NXCD = 8, WGM = 8;
__host__ __device__ __forceinline__ int lds_byte(int r, int c) { const int st = (r >> 4) * 2 + (c >> 5), rr = r & 15, cc = c & 31, ob = rr * 64 + cc * 2; return st * 1024 + (ob ^ (((ob >> 9) & 1) << 5)); }
__host__ __device__ __forceinline__ void stage_rc(int b, int& R, int& C) { const int st = b / 1024, sb = b % 1024, swz = sb ^ (((sb >> 9) & 1) << 5); R = (st >> 1) * 16 + swz / 64; C = (st & 1) * 32 + (swz % 64) / 2; }
__host__ __device__ __forceinline__ int perm32(int rho) { const int n = rho >> 4, i = rho & 15; return 8 * (i >> 2) + 4 * n + (i & 3); }
struct Unit { int pm, pn; };
struct Gemm { const bf16_t* A; const bf16_t* Bt; int M, N, K; };
struct StaticOrder {
    int nM, nN, nwg, G, c;
    __host__ __device__ void init(int M_, int N_, int G_, int c_) { nM = M_ / BM; nN = N_ / BM; nwg = nM * nN; G = G_; c = c_; }
    __host__ __device__ bool next(int i, Unit& u) const {
        const long L = (long)i * G + c; if (L >= nwg) return false;
        int wgid = (int)L; { const int q = nwg / NXCD, r = nwg % NXCD, xcd = wgid % NXCD, off = wgid / NXCD; wgid = (xcd < r ? xcd * (q + 1) : r * (q + 1) + (xcd - r) * q) + off; }
        const int nig = WGM * nN, gid = wgid / nig, fm = gid * WGM, gsz = (nM - fm) < WGM ? (nM - fm) : WGM;
        u.pm = fm + ((wgid % nig) % gsz); u.pn = (wgid % nig) / gsz; return true;
    }
    __device__ __forceinline__ void a_ready(const Unit&) const {}
    __device__ __forceinline__ void done(const Unit&) const {}
};
DI float rstd_of(const float* ss16) {
    const f32x4* p = (const f32x4*)ss16; const f32x4 a = p[0], b = p[1], c = p[2], d = p[3];
    const float s = (((a[0] + a[1]) + (a[2] + a[3])) + ((b[0] + b[1]) + (b[2] + b[3]))) + (((c[0] + c[1]) + (c[2] + c[3])) + ((d[0] + d[1]) + (d[2] + d[3])));
    return __builtin_amdgcn_rsqf(s * (1.f / 1024.f) + RMS_EPS);
}
DI float rstd_q(const f32x4 a) { const float s = swap32_sum(swap16_sum((a[0] + a[1]) + (a[2] + a[3]))); return __builtin_amdgcn_rsqf(s * (1.f / 1024.f) + RMS_EPS); }
struct EpiSwiglu {
    static constexpr bool PERM = true, AFTER_DRAIN = false;
    bf16_t* O; const float* ss;
    __device__ __forceinline__ void operator()(const f32x4 (&acc)[2][2][4][2], const Unit& u, int wr, int wc, int fr, int fq) const {
        const int row0 = u.pm * BM + wr * 64 + fr, col0 = u.pn * 128 + wc * 32 + 8 * fq;
        f32x4 sq[2][4];
#pragma unroll
        for (int ai = 0; ai < 2; ++ai)
#pragma unroll
            for (int m = 0; m < 4; ++m) sq[ai][m] = *(const f32x4*)(ss + (size_t)(row0 + ai * HALF + m * 16) * 16 + 4 * fq);
#pragma unroll
        for (int ai = 0; ai < 2; ++ai)
#pragma unroll
            for (int m = 0; m < 4; ++m) { const int row = row0 + ai * HALF + m * 16; const float rs = rstd_q(sq[ai][m]);
                u32x4 w;
#pragma unroll
                for (int n = 0; n < 2; ++n) { const f32x4 g = acc[ai][0][m][n] * rs, up = acc[ai][1][m][n] * rs;
                    const float a0 = siluf_(g[0]) * up[0], a1 = siluf_(g[1]) * up[1], a2 = siluf_(g[2]) * up[2], a3 = siluf_(g[3]) * up[3];
                    w[2 * n] = pkh2(a0, a1); w[2 * n + 1] = pkh2(a2, a3); }
                *(u32x4*)(O + ((size_t)(u.pm * (DFF / BK) + (col0 >> 6)) * BM + (row & (BM - 1))) * BK + (col0 & 63)) = w; asm volatile("" ::: "memory"); }
    }
};
struct EpiNull {
    static constexpr bool PERM = true, AFTER_DRAIN = false; float* sink;
    __device__ __forceinline__ void operator()(const f32x4 (&acc)[2][2][4][2], const Unit& u, int wr, int wc, int fr, int fq) const {
        float s = 0.f;
#pragma unroll
        for (int ai = 0; ai < 2; ++ai)
#pragma unroll
            for (int bj = 0; bj < 2; ++bj)
#pragma unroll
                for (int m = 0; m < 4; ++m)
#pragma unroll
                    for (int n = 0; n < 2; ++n) s += acc[ai][bj][m][n][0] + acc[ai][bj][m][n][3];
        if (s == 1.2345e33f) sink[u.pm] = s;
    }
};
struct EpiResid {
    static constexpr bool PERM = true, AFTER_DRAIN = false;
    bf16_t* x16; float* ss_out; float alpha; int row_off;
    __device__ __forceinline__ void operator()(const f32x4 (&acc)[2][2][4][2], const Unit& u, int wr, int wc, int fr, int fq) const {
        const int row0 = row_off + u.pm * BM + wr * 64 + fr, col0 = u.pn * BM + wc * 32 + 8 * fq;
#pragma unroll
        for (int ai = 0; ai < 2; ++ai) {
            u32x4 xw[4][2];
#pragma unroll
            for (int m = 0; m < 4; ++m)
#pragma unroll
                for (int bj = 0; bj < 2; ++bj) xw[m][bj] = *(const u32x4*)(x16 + (size_t)(row0 + ai * HALF + m * 16) * D + col0 + bj * HALF);
#pragma unroll
            for (int m = 0; m < 4; ++m) { const int row = row0 + ai * HALF + m * 16; float sq = 0.f;
#pragma unroll
                for (int bj = 0; bj < 2; ++bj) { const u32x4 x4 = xw[m][bj]; u32x4 w;
#pragma unroll
                    for (int n = 0; n < 2; ++n) { const f32x4 xi = {hlo_f(x4[2 * n]), hhi_f(x4[2 * n]), hlo_f(x4[2 * n + 1]), hhi_f(x4[2 * n + 1])}; const f32x4 xo = xi + acc[ai][bj][m][n] * alpha;
                        w[2 * n] = pkh2(xo[0], xo[1]); w[2 * n + 1] = pkh2(xo[2], xo[3]);
                        sq += (xo[0] * xo[0] + xo[1] * xo[1]) + (xo[2] * xo[2] + xo[3] * xo[3]); }
                    *(u32x4*)(x16 + (size_t)row * D + col0 + bj * HALF) = w; }
                sq += __shfl_xor(sq, 16); sq += __shfl_xor(sq, 32);
                if (fq == 0) ss_out[(size_t)row * 16 + u.pn * 4 + wc] = sq; }
        }
    }
};
struct EpiProj {
    static constexpr bool PERM = true, AFTER_DRAIN = false;
    bf16_t* O; const float* ss; const float* rcos; const float* rsin;
    const float* pcos; const float* psin; bf16_t* dvT;
    __device__ __forceinline__ void operator()(const f32x4 (&acc)[2][2][4][2], const Unit& u, int wr, int wc, int fr, int fq) const {
        const int row0 = u.pm * BM + wr * 64 + fr, col0 = u.pn * BM + wc * 32 + 8 * fq;
        f32x4 sq[2][4];
#pragma unroll
        for (int ai = 0; ai < 2; ++ai)
#pragma unroll
            for (int m = 0; m < 4; ++m) sq[ai][m] = *(const f32x4*)(ss + (size_t)(row0 + ai * HALF + m * 16) * 16 + 4 * fq);
        if (u.pn < 4) {
            const int d4 = 16 * (wc & 1) + 4 * fq; const float ksc = u.pn >= 2 ? 0.125f : 1.f;
#pragma unroll
            for (int ai = 0; ai < 2; ++ai)
#pragma unroll
                for (int m = 0; m < 4; ++m) { const int row = row0 + ai * HALF + m * 16; const float rs = rstd_q(sq[ai][m]) * ksc; const int pos = row & (T - 1);
                    const f32x4 c = *(const f32x4*)(rcos + pos * 32 + d4), sn = *(const f32x4*)(rsin + pos * 32 + d4);
#pragma unroll
                    for (int bj = 0; bj < 2; ++bj) { const f32x4 x1 = acc[ai][bj][m][0] * rs, x2 = acc[ai][bj][m][1] * rs; const f32x4 v0 = x1 * c - x2 * sn, v1 = x1 * sn + x2 * c;
                        u32x4 w; w.x = pk2(v0[0], v0[1]); w.y = pk2(v0[2], v0[3]); w.z = pk2(v1[0], v1[1]); w.w = pk2(v1[2], v1[3]);
                        *(u32x4*)(O + (size_t)row * NPROJ + col0 + bj * HALF) = w; } asm volatile("" ::: "memory"); }
            return; }
        if (u.pn >= 12 && u.pn < 16) {
            const bool lane_rope = ((wc & 1) == 0) && (fq < 2); const int a4 = 4 * (fq & 1);
#pragma unroll
            for (int ai = 0; ai < 2; ++ai)
#pragma unroll
                for (int m = 0; m < 4; ++m) { const int row = row0 + ai * HALF + m * 16; const float rs = rstd_q(sq[ai][m]); const int pos = row & (T - 1);
                    const f32x4 c = *(const f32x4*)(pcos + pos * 8 + a4), sn = *(const f32x4*)(psin + pos * 8 + a4);
#pragma unroll
                    for (int bj = 0; bj < 2; ++bj) { const int slot = (u.pn - 12) * 4 + bj * 2 + (wc >> 1); const float sc = rs * (slot < 8 ? DSA_QSCALE_C : 1.f);
                        const f32x4 x1 = acc[ai][bj][m][0] * sc, x2 = acc[ai][bj][m][1] * sc; f32x4 v0 = x1, v1 = x2;
                        if (lane_rope && slot != 9 && slot != 15) { v0 = x1 * c - x2 * sn; v1 = x1 * sn + x2 * c; }
                        u32x4 w; w.x = pk2(v0[0], v0[1]); w.y = pk2(v0[2], v0[3]); w.z = pk2(v1[0], v1[1]); w.w = pk2(v1[2], v1[3]);
                        *(u32x4*)(O + (size_t)row * NPROJ + col0 + bj * HALF) = w;
                        if (slot == 9) { bf16_t* vt = dvT + ((size_t)(row >> 11) * 64 + (wc & 1) * 32 + 8 * fq) * T + pos;
                            vt[0] = (bf16_t)(w.x & 0xffffu); vt[T] = (bf16_t)(w.x >> 16); vt[2 * T] = (bf16_t)(w.y & 0xffffu); vt[3 * T] = (bf16_t)(w.y >> 16);
                            vt[4 * T] = (bf16_t)(w.z & 0xffffu); vt[5 * T] = (bf16_t)(w.z >> 16); vt[6 * T] = (bf16_t)(w.w & 0xffffu); vt[7 * T] = (bf16_t)(w.w >> 16); } } asm volatile("" ::: "memory"); }
            return; }
#pragma unroll
        for (int ai = 0; ai < 2; ++ai)
#pragma unroll
            for (int m = 0; m < 4; ++m) { const int row = row0 + ai * HALF + m * 16; const float rs = rstd_q(sq[ai][m]);
#pragma unroll
                for (int bj = 0; bj < 2; ++bj) { const f32x4 v0 = acc[ai][bj][m][0] * rs, v1 = acc[ai][bj][m][1] * rs;
                    u32x4 w; w.x = pk2(v0[0], v0[1]); w.y = pk2(v0[2], v0[3]); w.z = pk2(v1[0], v1[1]); w.w = pk2(v1[2], v1[3]);
                    *(u32x4*)(O + (size_t)row * NPROJ + col0 + bj * HALF) = w; } asm volatile("" ::: "memory"); }
    }
};
template <int BR> struct EpiMerge {
    static constexpr bool PERM = false, AFTER_DRAIN = false;
    const bf16_t* proj; float* scratch; bf16_t* merged;
    __device__ __forceinline__ void operator()(const f32x4 (&acc)[2][2][4][2], const Unit& u, int wr, int wc, int fr, int fq) const {
        const int row0 = u.pm * BM + wr * 64 + fr, col0 = u.pn * BM + wc * 32 + 4 * fq;
#pragma unroll
        for (int ai = 0; ai < 2; ++ai)
#pragma unroll
            for (int m = 0; m < 4; ++m) { const int row = row0 + ai * HALF + m * 16;
#pragma unroll
                for (int bj = 0; bj < 2; ++bj)
#pragma unroll
                    for (int n = 0; n < 2; ++n) { const int c = col0 + bj * HALF + n * 16;
                        const u32x2 gw = *(const u32x2*)(proj + (size_t)row * NPROJ + C_GATE + BR * 1024 + c);
                        f32x4 g; g[0] = sigmoidf_(lo_f(gw.x)); g[1] = sigmoidf_(hi_f(gw.x)); g[2] = sigmoidf_(lo_f(gw.y)); g[3] = sigmoidf_(hi_f(gw.y));
                        f32x4 z = g * acc[ai][bj][m][n]; float* sp = scratch + (size_t)row * D + c;
                        if (BR == 0) { *(f32x4*)sp = z; }
                        else if (BR == 1) { z += *(const f32x4*)sp; *(f32x4*)sp = z; }
                        else { z += *(const f32x4*)sp; u32x2 w; w.x = pk2(z[0], z[1]); w.y = pk2(z[2], z[3]); *(u32x2*)(merged + (size_t)row * D + c) = w; } } }
    }
};

template <class Epi, class Sched, bool ALIGN_EPI = false, bool SP2 = false, bool ATILED = false>
__device__ __forceinline__ void gemm_phase(PG8_LAS unsigned char* lds, const Gemm g, const Sched& S, const Epi& E, const int tid) {
    const int wid = __builtin_amdgcn_readfirstlane(tid >> 6), lane = tid & 63, wr = wid >> 2, wc = wid & 3, fr = lane & 15, fq = lane >> 4;
    const int K = g.K, nt = K / BK;
    unsigned voffA[2], voffB[2];
#pragma unroll
    for (int i = 0; i < 2; ++i) { int R, C; stage_rc(tid * 16 + i * 8192, R, C); const int Rb = Epi::PERM ? ((R & ~31) + perm32(R & 31)) : R;
        voffA[i] = (unsigned)(R * (ATILED ? BK : K) + C) * 2u; voffB[i] = (unsigned)(Rb * K + C) * 2u; }
    const size_t kstep = (size_t)(BK * 2);
    const size_t hstep = (size_t)HALF * K * 2;
    const size_t tstep = 2 * hstep;
    const size_t kstepA = ATILED ? (size_t)(BM * BK * 2) : kstep, hstepA = ATILED ? (size_t)(HALF * BK * 2) : hstep;
    const unsigned ldsw = (unsigned)wid * 1024u;
    const int aoff = lds_byte(wr * 64 + fr, fq * 8), boff = lds_byte(wc * 32 + fr, fq * 8);
#define PG8_SA(b, h) (((b) * 2 + (h)) * HTB)
#define PG8_SB(b, h) ((4 + (b) * 2 + (h)) * HTB)
#define PG8_STAGE(bufoff, gbase, voff) do { _Pragma("unroll") for (int _i = 0; _i < 2; ++_i) \
        __builtin_amdgcn_global_load_lds((const unsigned*)((const char*)(gbase) + (voff)[_i]), (PG8_LAS unsigned*)(lds + (bufoff) + ldsw + _i * 8192), 16, 0, 0); } while (0)
#define PG8_LDA(dst, b, h) do { _Pragma("unroll") for (int m = 0; m < 4; ++m) _Pragma("unroll") for (int k = 0; k < 2; ++k) dst[m][k] = *(const PG8_LAS bf16x8*)(lds + PG8_SA(b, h) + aoff + m * 2048 + k * 1024); } while (0)
#define PG8_LDB(dst, b, h) do { _Pragma("unroll") for (int n = 0; n < 2; ++n) _Pragma("unroll") for (int k = 0; k < 2; ++k) dst[n][k] = *(const PG8_LAS bf16x8*)(lds + PG8_SB(b, h) + boff + n * 2048 + k * 1024); } while (0)
#define PG8_MMA(ai, bj, At, Bt) do { __builtin_amdgcn_s_setprio(1); _Pragma("unroll") for (int m = 0; m < 4; ++m) _Pragma("unroll") for (int n = 0; n < 2; ++n) _Pragma("unroll") for (int k = 0; k < 2; ++k) \
        acc[ai][bj][m][n] = GEMM_MFMA16(Bt[n][k], At[m][k], acc[ai][bj][m][n]); __builtin_amdgcn_s_setprio(0); } while (0)
#define PG8_WAIT_V(n) asm volatile("s_waitcnt vmcnt(" #n ")" ::: "memory")
#define PG8_WAIT_L(n) asm volatile("s_waitcnt lgkmcnt(" #n ")" ::: "memory")
#define PG8_BAR __builtin_amdgcn_s_barrier()
#define PG8_SCHED __builtin_amdgcn_sched_barrier(0)
    Unit cur, nxt; int ui = 0;
    if (!S.next(0, cur)) return;
    f32x4 acc[2][2][4][2];
#pragma unroll
    for (int a = 0; a < 2; ++a)
#pragma unroll
        for (int b = 0; b < 2; ++b)
#pragma unroll
            for (int m = 0; m < 4; ++m)
#pragma unroll
                for (int n = 0; n < 2; ++n) acc[a][b][m][n] = (f32x4){0.f, 0.f, 0.f, 0.f};
    bf16x8 At[4][2], B0[2][2], B1[2][2];
    const char* cA = (const char*)g.A + (size_t)cur.pm * tstep; const char* cB = (const char*)g.Bt + (size_t)cur.pn * tstep;
    S.a_ready(cur);
    if constexpr (SP2) {
        PG8_STAGE(PG8_SB(0, 0), cB, voffB); PG8_STAGE(PG8_SB(0, 1), cB + hstep, voffB); PG8_STAGE(PG8_SA(0, 0), cA, voffA); PG8_STAGE(PG8_SA(0, 1), cA + hstepA, voffA);
        if (wr == 1) PG8_BAR;
        PG8_WAIT_V(2); PG8_BAR;
        PG8_STAGE(PG8_SB(1, 0), cB + kstep, voffB); PG8_STAGE(PG8_SA(1, 0), cA + kstepA, voffA); PG8_STAGE(PG8_SB(1, 1), cB + hstep + kstep, voffB);
        PG8_WAIT_V(6); PG8_BAR;
    } else {
        PG8_STAGE(PG8_SB(0, 0), cB, voffB); PG8_STAGE(PG8_SA(0, 0), cA, voffA); PG8_STAGE(PG8_SB(0, 1), cB + hstep, voffB); PG8_STAGE(PG8_SA(0, 1), cA + hstepA, voffA);
        if (wr == 1) PG8_BAR;
        PG8_WAIT_V(4); PG8_BAR;
        PG8_STAGE(PG8_SB(1, 0), cB + kstep, voffB); PG8_STAGE(PG8_SA(1, 0), cA + kstepA, voffA); PG8_STAGE(PG8_SB(1, 1), cB + hstep + kstep, voffB);
        PG8_WAIT_V(6); PG8_BAR;
    }
    for (;;) {
        const bool has_next = S.next(ui + 1, nxt);
        const char* nA = has_next ? (const char*)g.A + (size_t)nxt.pm * tstep : cA; const char* nB = has_next ? (const char*)g.Bt + (size_t)nxt.pn * tstep : cB;
        for (int t = 0; t < nt; t += 2) {
            const bool last = (t == nt - 2);
            const char* a1 = cA + (size_t)(t + 1) * kstepA;
            const char* a2 = last ? nA : cA + (size_t)(t + 2) * kstepA; const char* b2 = last ? nB : cB + (size_t)(t + 2) * kstep;
            const char* a3 = a2 + kstepA; const char* b3 = b2 + kstep;
            if (last && has_next) S.a_ready(nxt);
            if constexpr (SP2) {
            PG8_LDB(B0, 0, 0); PG8_LDB(B1, 0, 1); PG8_SCHED; PG8_LDA(At, 0, 0); PG8_STAGE(PG8_SA(1, 1), a1 + hstepA, voffA);
            PG8_WAIT_V(8); PG8_WAIT_L(0); PG8_BAR; PG8_MMA(0, 0, At, B0); PG8_MMA(0, 1, At, B1); PG8_BAR; PG8_SCHED;
            PG8_LDA(At, 0, 1); PG8_STAGE(PG8_SB(0, 0), b2, voffB); PG8_STAGE(PG8_SB(0, 1), b2 + hstep, voffB); PG8_STAGE(PG8_SA(0, 0), a2, voffA);
            PG8_WAIT_V(8); PG8_WAIT_L(0); PG8_BAR; PG8_MMA(1, 0, At, B0); PG8_MMA(1, 1, At, B1); PG8_BAR; PG8_SCHED;
            PG8_LDB(B0, 1, 0); PG8_LDB(B1, 1, 1); PG8_SCHED; PG8_LDA(At, 1, 0); PG8_STAGE(PG8_SA(0, 1), a2 + hstepA, voffA);
            PG8_WAIT_V(8); PG8_WAIT_L(0); PG8_BAR; PG8_MMA(0, 0, At, B0); PG8_MMA(0, 1, At, B1); PG8_BAR; PG8_SCHED;
            PG8_LDA(At, 1, 1); PG8_STAGE(PG8_SB(1, 0), b3, voffB); PG8_STAGE(PG8_SB(1, 1), b3 + hstep, voffB); PG8_STAGE(PG8_SA(1, 0), a3, voffA);
            PG8_WAIT_V(8); PG8_WAIT_L(0); PG8_BAR; PG8_MMA(1, 0, At, B0); PG8_MMA(1, 1, At, B1); PG8_BAR; PG8_SCHED;
            } else {
            PG8_LDB(B0, 0, 0); PG8_SCHED; PG8_LDA(At, 0, 0); PG8_STAGE(PG8_SA(1, 1), a1 + hstepA, voffA);
            PG8_WAIT_L(8); PG8_BAR; PG8_WAIT_L(0); PG8_MMA(0, 0, At, B0); PG8_BAR; PG8_SCHED;
            PG8_LDB(B1, 0, 1); PG8_STAGE(PG8_SB(0, 0), b2, voffB);
            PG8_BAR; PG8_WAIT_L(0); PG8_MMA(0, 1, At, B1); PG8_BAR;
            PG8_LDA(At, 0, 1); PG8_STAGE(PG8_SA(0, 0), a2, voffA);
            PG8_BAR; PG8_WAIT_L(0); PG8_MMA(1, 0, At, B0); PG8_BAR; PG8_SCHED;
            PG8_STAGE(PG8_SB(0, 1), b2 + hstep, voffB);
            PG8_WAIT_V(6); PG8_BAR; PG8_MMA(1, 1, At, B1); PG8_BAR;
            PG8_LDB(B0, 1, 0); PG8_SCHED; PG8_LDA(At, 1, 0); PG8_STAGE(PG8_SA(0, 1), a2 + hstepA, voffA);
            PG8_WAIT_L(8); PG8_BAR; PG8_WAIT_L(0); PG8_MMA(0, 0, At, B0); PG8_BAR; PG8_SCHED;
            PG8_LDB(B1, 1, 1); PG8_STAGE(PG8_SB(1, 0), b3, voffB);
            PG8_BAR; PG8_WAIT_L(0); PG8_MMA(0, 1, At, B1); PG8_BAR;
            PG8_LDA(At, 1, 1); PG8_STAGE(PG8_SA(1, 0), a3, voffA);
            PG8_BAR; PG8_WAIT_L(0); PG8_MMA(1, 0, At, B0); PG8_BAR; PG8_SCHED;
            PG8_STAGE(PG8_SB(1, 1), b3 + hstep, voffB);
            PG8_WAIT_V(6); PG8_BAR; PG8_MMA(1, 1, At, B1); PG8_BAR;
            }
        }
        if constexpr (ALIGN_EPI) { if (wr == 0) PG8_BAR; }
        if constexpr (!Epi::AFTER_DRAIN) { E(acc, cur, wr, wc, fr, fq); S.done(cur); }
        if (!has_next) break;
#pragma unroll
        for (int a = 0; a < 2; ++a)
#pragma unroll
            for (int b = 0; b < 2; ++b)
#pragma unroll
                for (int m = 0; m < 4; ++m)
#pragma unroll
                    for (int n = 0; n < 2; ++n) acc[a][b][m][n] = (f32x4){0.f, 0.f, 0.f, 0.f};
        cur = nxt; cA = nA; cB = nB; ++ui;
        if constexpr (ALIGN_EPI) { if (wr == 1) PG8_BAR; }
    }
    PG8_WAIT_V(0);
    if constexpr (!ALIGN_EPI) { if (wr == 0) PG8_BAR; }
    PG8_BAR;
#undef PG8_SA
#undef PG8_SB
#undef PG8_STAGE
#undef PG8_LDA
#undef PG8_LDB
#undef PG8_MMA
#undef PG8_WAIT_V
#undef PG8_WAIT_L
#undef PG8_BAR
#undef PG8_SCHED
}
struct UnitH { int pm, pn, br; };
template <class Epi, class Sched, int LD>
__device__ __forceinline__ void gemm_nhalf_phase(PG8_LAS unsigned char* lds, const Sched& S, Epi& E, const int tid) {
    const int wid = __builtin_amdgcn_readfirstlane(tid >> 6), lane = tid & 63, wr = wid >> 2, wc = wid & 3, fr = lane & 15, fq = lane >> 4;
    unsigned voff[2], voffB[2];
#pragma unroll
    for (int i = 0; i < 2; ++i) { int R, C; stage_rc(tid * 16 + i * 8192, R, C); voff[i] = (unsigned)(R * LD + C) * 2u; voffB[i] = (unsigned)(((R & ~31) + perm32(R & 31)) * LD + C) * 2u; }
    const size_t kstep = (size_t)(BK * 2);
    const size_t hstep = (size_t)HALF * LD * 2;
    const unsigned ldsw = (unsigned)wid * 1024u;
    const int aoff = lds_byte(wr * 64 + fr, fq * 8), boff = lds_byte(wc * 32 + fr, fq * 8);
#define NH_BUF(b, h) (((b) * 3 + (h)) * HTB)
#define NH_STAGE(bufoff, gbase, vo) do { _Pragma("unroll") for (int _i = 0; _i < 2; ++_i) \
        __builtin_amdgcn_global_load_lds((const unsigned*)((const char*)(gbase) + (vo)[_i]), (PG8_LAS unsigned*)(lds + (bufoff) + ldsw + _i * 8192), 16, 0, 0); } while (0)
#define NH_STAGE3(b, pa, pb) do { NH_STAGE(NH_BUF(b, 2), pb, voffB); NH_STAGE(NH_BUF(b, 0), pa, voff); NH_STAGE(NH_BUF(b, 1), (pa) + hstep, voff); } while (0)
#define NH_BAR __builtin_amdgcn_s_barrier()
    UnitH cur, nxt;
    if (!S.next(0, cur)) return;
    f32x4 acc[2][4][2];
#pragma unroll
    for (int a = 0; a < 2; ++a)
#pragma unroll
        for (int m = 0; m < 4; ++m)
#pragma unroll
            for (int n = 0; n < 2; ++n) acc[a][m][n] = (f32x4){0.f, 0.f, 0.f, 0.f};
    const char* cA; const char* cB; int nt; S.bases(cur, cA, cB, nt);
    int pi = 0, pt = 0; UnitH pu = cur; const char* pA = cA; const char* pB = cB; int pnt = nt; bool pvalid = true;
    auto padvance = [&]() { if (!pvalid) return; if (++pt == pnt) { UnitH nu; if (S.next(pi + 1, nu)) { ++pi; pu = nu; S.bases(pu, pA, pB, pnt); pt = 0; } else pvalid = false; } };
    NH_STAGE3(0, pA, pB); padvance();
    if (pvalid) { NH_STAGE3(1, pA + (size_t)pt * kstep, pB + (size_t)pt * kstep); } padvance();
    asm volatile("s_waitcnt vmcnt(6)" ::: "memory");
    NH_BAR;
    if (wr == 1) NH_BAR;
    int ui = 0, bufc = 0;
    for (;;) {
        const bool has_next = S.next(ui + 1, nxt);
        for (int t = 0; t < nt; ++t) {
            bf16x8 At[2][4][2], B0[2][2];
#pragma unroll
            for (int n = 0; n < 2; ++n)
#pragma unroll
                for (int k = 0; k < 2; ++k) B0[n][k] = *(const PG8_LAS bf16x8*)(lds + NH_BUF(bufc, 2) + boff + n * 2048 + k * 1024);
#pragma unroll
            for (int a = 0; a < 2; ++a)
#pragma unroll
                for (int m = 0; m < 4; ++m)
#pragma unroll
                    for (int k = 0; k < 2; ++k) At[a][m][k] = *(const PG8_LAS bf16x8*)(lds + NH_BUF(bufc, a) + aoff + m * 2048 + k * 1024);
            const int bufn = bufc >= 1 ? bufc - 1 : 2;
            if (pvalid) { NH_STAGE3(bufn, pA + (size_t)pt * kstep, pB + (size_t)pt * kstep); asm volatile("s_waitcnt vmcnt(6)" ::: "memory"); }
            else asm volatile("s_waitcnt vmcnt(0)" ::: "memory");
            padvance();
            asm volatile("s_waitcnt lgkmcnt(0)" ::: "memory");
            NH_BAR;
            __builtin_amdgcn_s_setprio(1);
#pragma unroll
            for (int a = 0; a < 2; ++a)
#pragma unroll
                for (int m = 0; m < 4; ++m)
#pragma unroll
                    for (int n = 0; n < 2; ++n)
#pragma unroll
                        for (int k = 0; k < 2; ++k) acc[a][m][n] = GEMM_MFMA16(B0[n][k], At[a][m][k], acc[a][m][n]);
            __builtin_amdgcn_s_setprio(0);
            NH_BAR;
            bufc = bufc == 2 ? 0 : bufc + 1;
        }
        if constexpr (!Epi::AFTER_DRAIN) E(acc, cur, wr, wc, fr, fq);
        if (!has_next) break;
#pragma unroll
        for (int a = 0; a < 2; ++a)
#pragma unroll
            for (int m = 0; m < 4; ++m)
#pragma unroll
                for (int n = 0; n < 2; ++n) acc[a][m][n] = (f32x4){0.f, 0.f, 0.f, 0.f};
        cur = nxt; S.bases(cur, cA, cB, nt); ++ui;
    }
    asm volatile("s_waitcnt vmcnt(0)" ::: "memory");
    if (wr == 0) NH_BAR;
    NH_BAR;
    if constexpr (Epi::AFTER_DRAIN) E.fused(acc, cur, wr, wc, fr, fq, lds, tid);
#undef NH_BUF
#undef NH_STAGE
#undef NH_STAGE3
#undef NH_BAR
}
struct MergeSched {
    const char *Aret, *Adr, *Bret, *Bdr; int ntiles, c, nN;
    __device__ __forceinline__ bool next(int i, UnitH& u) const { if (c >= ntiles || i >= 3) return false; const int x = c & 7, r = c >> 3, ppx = ntiles / nN / 8; u.pm = x * ppx + r / nN; u.pn = r % nN; u.br = i; return true; }
    __device__ __forceinline__ void bases(const UnitH& u, const char*& A, const char*& B, int& nt) const {
        const size_t ao = (size_t)u.pm * 256 * 1024 * 2, bo = (size_t)u.pn * 128 * 1024 * 2;
        if (u.br == 0) { A = Aret + ao; B = Bret + bo; nt = 16; } else { A = Adr + ao + (u.br == 2 ? 1024 : 0); B = Bdr + bo + (u.br == 2 ? 1024 : 0); nt = 8; }
    }
};
struct EpiMerge3 {
    static constexpr bool AFTER_DRAIN = false;
    const bf16_t* proj; bf16_t* merged; f32x4 ms[2][4][2];
    __device__ __forceinline__ void operator()(const f32x4 (&acc)[2][4][2], const UnitH& u, int wr, int wc, int fr, int fq) {
        const int row0 = u.pm * BM + wr * 64 + fr, col0 = u.pn * 128 + wc * 32 + 8 * fq;
        u32x4 gw[2][4];
#pragma unroll
        for (int ai = 0; ai < 2; ++ai)
#pragma unroll
            for (int m = 0; m < 4; ++m) gw[ai][m] = *(const u32x4*)(proj + (size_t)(row0 + ai * HALF + m * 16) * NPROJ + C_GATE + u.br * 1024 + col0);
#pragma unroll
        for (int ai = 0; ai < 2; ++ai)
#pragma unroll
            for (int m = 0; m < 4; ++m) { const int row = row0 + ai * HALF + m * 16; const u32x4 g4 = gw[ai][m]; u32x4 w;
#pragma unroll
                for (int n = 0; n < 2; ++n) {
                    f32x4 g; g[0] = sigmoidf_(lo_f(g4[2 * n])); g[1] = sigmoidf_(hi_f(g4[2 * n])); g[2] = sigmoidf_(lo_f(g4[2 * n + 1])); g[3] = sigmoidf_(hi_f(g4[2 * n + 1]));
                    const f32x4 z = g * acc[ai][m][n];
                    if (u.br == 0) ms[ai][m][n] = z; else ms[ai][m][n] += z;
                    const f32x4 t = ms[ai][m][n]; w[2 * n] = pkh2(t[0], t[1]); w[2 * n + 1] = pkh2(t[2], t[3]); }
                if (u.br == 2) *(u32x4*)(merged + (size_t)row * D + col0) = w; }
    }
};
struct OneSchedH {
    const char *A, *B; int ntiles, c, nN, nt;
    __device__ __forceinline__ bool next(int i, UnitH& u) const { if (c >= ntiles || i >= 1) return false; const int x = c & 7, r = c >> 3, ppx = ntiles / nN / 8; u.pm = x * ppx + r / nN; u.pn = r % nN; u.br = 0; return true; }
    __device__ __forceinline__ void bases(const UnitH& u, const char*& a, const char*& b, int& nt_) const { a = A + (size_t)u.pm * 256 * 1024 * 2; b = B + (size_t)u.pn * 128 * 1024 * 2; nt_ = nt; }
};
struct EpiResidH {
    static constexpr bool AFTER_DRAIN = true;
    bf16_t* x16; float* ss_out; float alpha; int row_off;
    __device__ __forceinline__ void fused(const f32x4 (&acc)[2][4][2], const UnitH& u, int wr, int wc, int fr, int fq, PG8_LAS unsigned char* lds, int tid) const {
        PG8_LAS float* tab = (PG8_LAS float*)lds;
        const int col0 = u.pn * 128 + wc * 32 + 8 * fq;
        u32x4 xw[2][4];
#pragma unroll
        for (int ai = 0; ai < 2; ++ai)
#pragma unroll
            for (int m = 0; m < 4; ++m) xw[ai][m] = *(const u32x4*)(x16 + (size_t)(row_off + u.pm * BM + ai * HALF + wr * 64 + m * 16 + fr) * D + col0);
#pragma unroll
        for (int ai = 0; ai < 2; ++ai)
#pragma unroll
            for (int m = 0; m < 4; ++m) { const int rl = ai * HALF + wr * 64 + m * 16 + fr; const int row = row_off + u.pm * BM + rl; float sq = 0.f; const u32x4 x4 = xw[ai][m]; u32x4 w;
#pragma unroll
                for (int n = 0; n < 2; ++n) { const f32x4 xi = {hlo_f(x4[2 * n]), hhi_f(x4[2 * n]), hlo_f(x4[2 * n + 1]), hhi_f(x4[2 * n + 1])}; const f32x4 xo = xi + acc[ai][m][n] * alpha;
                    w[2 * n] = pkh2(xo[0], xo[1]); w[2 * n + 1] = pkh2(xo[2], xo[3]);
                    sq += (xo[0] * xo[0] + xo[1] * xo[1]) + (xo[2] * xo[2] + xo[3] * xo[3]); }
                *(u32x4*)(x16 + (size_t)row * D + col0) = w;
                sq += __shfl_xor(sq, 16); sq += __shfl_xor(sq, 32);
                if (fq == 0) tab[rl * 4 + wc] = sq; }
        __syncthreads();
        { const int t = tid; const int rl = t >> 1, hf = t & 1;
          ss_out[(size_t)(row_off + u.pm * BM + rl) * 16 + u.pn * 2 + hf] = tab[rl * 4 + 2 * hf] + tab[rl * 4 + 2 * hf + 1]; }
    }
};
}
#ifndef PG8_SP2
#define PG8_SP2 true
#endif
#ifndef PG8_ALIGN
#define PG8_ALIGN true
#endif

constexpr size_t MiB = 1u << 20;
constexpr size_t WS_CTL = 0, CTL_ZERO_BYTES = 1 * MiB;
constexpr size_t WS_TAB = 1 * MiB;
constexpr size_t TAB_RCOS = 0, TAB_RSIN = (size_t)T * 32 * 4, TAB_PCOS = 2 * (size_t)T * 32 * 4, TAB_PSIN = TAB_PCOS + (size_t)T * 8 * 4;
constexpr size_t WS_SS = 2 * MiB, SS_BYTES = (size_t)M * 16 * 4;
constexpr size_t WS_XB = 16 * MiB;
constexpr size_t WS_W = 80 * MiB, W_LAYER_BYTES = 58 * MiB;
constexpr size_t WO_FFA_IN = 0, WO_FFA_OUT = WO_FFA_IN + (size_t)2 * DFF * D, WO_WIN = WO_FFA_OUT + (size_t)D * DFF, WO_PRET = WO_WIN + (size_t)NPROJ * D,
                 WO_PDR = WO_PRET + (size_t)D * 1024, WO_WOUT = WO_PDR + (size_t)D * 1024, WO_FFB_IN = WO_WOUT + (size_t)D * D,
                 WO_FFB_OUT = WO_FFB_IN + (size_t)2 * DFF * D, WO_W2T = WO_FFB_OUT + (size_t)D * DFF, WO_A2T = WO_W2T + 512 * 64, WO_G2T = WO_A2T + 512 * 64, WO_END = WO_G2T + 512 * 128;
static_assert(WO_END * 2 <= W_LAYER_BYTES, "weights fit");
constexpr size_t WS_GRP = 196 * MiB;
constexpr size_t WS_ACT = WS_GRP;
constexpr size_t WS_PROJ = WS_GRP;
constexpr size_t WS_PR = WS_GRP + 144 * MiB, WS_PK = WS_PR + 8 * MiB, WS_PV = WS_PK + 8 * MiB, WS_PKK = WS_PV + 8 * MiB, WS_PB = WS_PKK + 8 * MiB;
constexpr size_t WS_PW = WS_PB + 8 * MiB;
constexpr size_t WS_PG = WS_PW + 16 * MiB;
constexpr size_t WS_PC = WS_PG + 8 * MiB;
constexpr size_t WS_RQR = WS_PR, WS_RKR = WS_PK, WS_RVT = WS_PW;
constexpr size_t WS_RS = WS_PKK;
constexpr size_t WS_SCR = WS_PR;
constexpr size_t WS_YRET = WS_PC + 1 * MiB, WS_YDR = WS_YRET + 16 * MiB;
constexpr size_t WS_MERGED = WS_YDR + 16 * MiB;
constexpr size_t WS_MASK = WS_MERGED + 16 * MiB;
constexpr int NCHAIN = BG * 8, NRCH = T / 64;
constexpr size_t WS_RG = WS_MASK + 2 * MiB;
constexpr size_t WS_RRP = WS_RG + 8 * MiB, WS_RH = WS_RRP + 8 * MiB, WS_RY0 = WS_RH + 8 * MiB, WS_RSC = WS_RY0 + 16 * MiB;
constexpr size_t WS_RU = WS_RSC + 8 * MiB;
constexpr size_t WS_VT = WS_RU + 8 * MiB;
constexpr size_t WS_END = WS_VT + 1 * MiB;
static_assert((size_t)NCHAIN * NRCH * 64 * 64 * 2 <= 8 * MiB, "rwkv item buffers");
static_assert(WS_END <= 512 * MiB && WS_ACT + (size_t)M * DFF * 2 <= 512 * MiB, "workspace map");
constexpr int CW_BAR = 4096, CW_QUEUE = 16384;

constexpr int LDS_BYTES = 163840, MISC_OFF = LDS_BYTES - 256;

#define XB_TMO      128
#define XB_XCNT(j)  (256  + 64 * (j))
#define XB_XSUB(j)  (1280 + 64 * (j))
#define XB_XGEN(j)  (2304 + 64 * (j))
#define XB_TOP      3328
#define XB_TOPGEN   3392
#define XCD_BAR_WORDS 3456
#define XB_SPIN_CAP (1u << 18)
__device__ __forceinline__ unsigned xb_ld(unsigned* p)              { return __hip_atomic_load(p, __ATOMIC_RELAXED, __HIP_MEMORY_SCOPE_AGENT); }
__device__ __forceinline__ unsigned xb_add(unsigned* p, unsigned v) { return __hip_atomic_fetch_add(p, v, __ATOMIC_RELAXED, __HIP_MEMORY_SCOPE_AGENT); }
__device__ __forceinline__ unsigned xb_xcc_id() { return (unsigned)__builtin_amdgcn_s_getreg((3 << 11) | 20) & 0xFu; }
#define XB_SPIN(cond, bar) do { unsigned _sp = 0; while (cond) { __builtin_amdgcn_s_sleep(1); \
    if ((++_sp & 255u) == 0u) { if (xb_ld(&(bar)[XB_TMO])) break; if (_sp > XB_SPIN_CAP) { atomicAdd(&(bar)[XB_TMO], 1u); break; } } } } while (0)
struct XcdBarrier { unsigned* bar; unsigned x; volatile LAS unsigned* st; };
__device__ __forceinline__ XcdBarrier xcd_barrier_post(unsigned* bar, volatile LAS unsigned* st) {
    XcdBarrier b; b.bar = bar; b.x = xb_xcc_id(); b.st = st;
    if (threadIdx.x == 0) (void)xb_add(&bar[XB_XCNT(b.x)], 1u);
    return b;
}
__device__ __forceinline__ void xcd_barrier_complete(unsigned* bar, unsigned x, unsigned& nloc, unsigned& nx) {
    const unsigned G = gridDim.x * gridDim.y * gridDim.z;
    unsigned sum, cnt, mine, sp = 0u;
    for (;;) {
        sum = 0u; cnt = 0u; mine = 0u;
#pragma unroll
        for (unsigned j = 0; j < 16; ++j) { const unsigned c = xb_ld(&bar[XB_XCNT(j)]); sum += c; cnt += (c > 0u) ? 1u : 0u; mine = (j == x) ? c : mine; }
        if (sum == G) break;
        __builtin_amdgcn_s_sleep(1);
        if ((++sp & 255u) == 0u) { if (xb_ld(&bar[XB_TMO])) break; if (sp > XB_SPIN_CAP) { atomicAdd(&bar[XB_TMO], 1u); break; } }
    }
    nloc = mine > 0u ? mine : 1u; nx = cnt > 0u ? cnt : 1u;
}
__device__ __forceinline__ void xcd_barrier(const XcdBarrier& b) {
    asm volatile("s_waitcnt vmcnt(0)" ::: "memory");
    __syncthreads();
    if (threadIdx.x == 0) {
        unsigned* bar = b.bar;
        __builtin_amdgcn_s_waitcnt(0);
        unsigned nloc = b.st[0], nx = b.st[1];
        if (nloc == 0u) { xcd_barrier_complete(bar, b.x, nloc, nx); b.st[0] = nloc; b.st[1] = nx; }
        const unsigned old = xb_add(&bar[XB_XSUB(b.x)], 1u);
        const unsigned gen = old / nloc;
        if (old + 1u == (gen + 1u) * nloc) {
            __builtin_amdgcn_fence(__ATOMIC_RELEASE, "agent");
            asm volatile("s_waitcnt vmcnt(0)" ::: "memory");
            const unsigned og = xb_add(&bar[XB_TOP], 1u);
            const unsigned tg = og / nx;
            if (og + 1u == (tg + 1u) * nx) xb_add(&bar[XB_TOPGEN], 1u);
            else XB_SPIN(xb_ld(&bar[XB_TOPGEN]) == tg, bar);
            __builtin_amdgcn_fence(__ATOMIC_ACQUIRE, "agent");
            xb_add(&bar[XB_XGEN(b.x)], 1u);
            asm volatile("s_waitcnt vmcnt(0)" ::: "memory");
        } else {
            XB_SPIN(xb_ld(&bar[XB_XGEN(b.x)]) == gen, bar);
            __builtin_amdgcn_fence(__ATOMIC_ACQUIRE, "agent");
            asm volatile("s_waitcnt vmcnt(0)" ::: "memory");
        }
    }
    __syncthreads();
}

struct Args { const float* in[25]; float* out; unsigned char* ws; float inv_ret[32]; float inv_rot[8]; };
enum { I_X = 0, I_NORM_FFA, I_FFA_WIN, I_FFA_WOUT, I_NORM_MIX, I_WIN, I_MU, I_W0, I_W2, I_A0, I_A2, I_G2, I_KK, I_KA, I_RK, I_LNW, I_LNB, I_PRET, I_PDSA, I_PRWKV, I_WOUT,
       I_NORM_FFB, I_FFB_WIN, I_FFB_WOUT, I_NORM_FINAL };

DI int src_col(int kind, int nd) {
    if (kind == 0) return nd;
    if (kind == 1) { const int pn = nd >> 8, j = nd & 255; return j < 128 ? 128 * pn + j : DFF + 128 * pn + (j - 128); }
    if (nd < 1024) { const int p = nd & 63, j = p >> 3, i = p & 7; return (nd & ~63) + ((i < 4) ? 4 * j + i : 32 + 4 * j + (i - 4)); }
    if (nd >= 3072 && nd < 4032) { const int slot = (nd - 3072) >> 6, p = nd & 63;
        if (slot != 9 && p < 16) { const int j = p >> 3, i = p & 7; return (nd & ~63) + ((i < 4) ? 4 * j + i : 8 + 4 * j + (i - 4)); } }
    if (nd < 4036) return nd; if (nd < 4096) return -1; if (nd < 8960) return nd - 60; return -1;
}
DI void cvt_item(const float* W, int K, int Nsrc, bf16* WT, int ldw, int kind, const float* gain, LAS float* scr, int item, int nblk, int lane, bool f16) {
    const int kb = item / nblk, nb = item % nblk, k0 = 64 * kb, n0 = 32 * nb;
    const int sc = src_col(kind, n0 + (lane & 31));
    float vv[32];
#pragma unroll
    for (int i = 0; i < 32; ++i) { const int kk = 2 * i + (lane >> 5); vv[i] = (sc >= 0) ? W[(size_t)(k0 + kk) * Nsrc + sc] : 0.f; }
#pragma unroll
    for (int i = 0; i < 32; ++i) { const int kk = 2 * i + (lane >> 5); float v = vv[i]; if (gain) v *= gain[k0 + kk]; scr[kk * 33 + (lane & 31)] = v; }
    LDS_WAIT();
    const int c = lane & 7;
#pragma unroll
    for (int j = 0; j < 4; ++j) { const int n = (lane >> 3) + 8 * j; const LAS float* s = scr + (8 * c) * 33 + n;
        u32x4 o;
        if (f16) { o.x = pkh2(s[0 * 33], s[1 * 33]); o.y = pkh2(s[2 * 33], s[3 * 33]); o.z = pkh2(s[4 * 33], s[5 * 33]); o.w = pkh2(s[6 * 33], s[7 * 33]); }
        else { o.x = pk2(s[0 * 33], s[1 * 33]); o.y = pk2(s[2 * 33], s[3 * 33]); o.z = pk2(s[4 * 33], s[5 * 33]); o.w = pk2(s[6 * 33], s[7 * 33]); }
        *(u32x4*)(WT + (size_t)(n0 + n) * ldw + k0 + 8 * c) = o; }
    LDS_WAIT();
}
DI void sincos_d(float angf, float& c, float& s) {
    const double x = (double)angf; const double n = __builtin_rint(x * 0.15915494309189535); double r = __builtin_fma(-n, 6.283185307179586, x); r = __builtin_fma(-n, 2.4492935982947064e-16, r);
    const double r2 = r * r; double cs = 1.0, sn = r, tc = 1.0, tsn = r;
#pragma unroll 1
    for (int k = 1; k <= 14; ++k) { tc = -tc * r2 / (double)((2 * k - 1) * (2 * k)); tsn = -tsn * r2 / (double)((2 * k) * (2 * k + 1)); cs += tc; sn += tsn; }
    c = (float)cs; s = (float)sn;
}

struct Ctx { ldsp lds; int tid, lane, wave, G, blk; };
DI Ctx fresh(const Ctx& C0) { Ctx C = C0; asm volatile("" : "+v"(C.tid)); C.lane = C.tid & 63; C.wave = __builtin_amdgcn_readfirstlane(C.tid >> 6); asm volatile("" : "+s"(C.blk)); asm volatile("" : "+s"(C.G)); return C; }
typedef const __attribute__((address_space(4))) Args* kargp;
DI kargp kargs() { kargp p = (kargp)__builtin_amdgcn_kernarg_segment_ptr(); asm volatile("" : "+s"(p)); return p; }

DI void p0_prologue(const Ctx& C) {
    const kargp ap = kargs(); unsigned char* const ws = ap->ws;
    LAS float* scr = (LAS float*)(C.lds + C.wave * 16384);
    const int gw = C.blk * 8 + C.wave, NGW = C.G * 8;
    constexpr int I_FFIN = (D / 64) * (2 * DFF / 32), I_FFOUT = (DFF / 64) * (D / 32), I_WINP = (D / 64) * (NPROJ / 32), I_PR = (1024 / 64) * (D / 32), I_PD = (512 / 64) * (D / 32),
                  I_WO = (D / 64) * (D / 32), I_L64 = 1 * (512 / 32), I_L128 = 2 * (512 / 32);
    constexpr int PER_LAYER = 2 * I_FFIN + 2 * I_FFOUT + I_WINP + I_PR + 2 * I_PD + I_WO + 2 * I_L64 + I_L128;
    for (int it = gw; it < DEPTH * PER_LAYER; it += NGW) {
        const int l = it / PER_LAYER; int r = it - l * PER_LAYER;
        bf16* wl = (bf16*)(ws + WS_W + (size_t)l * W_LAYER_BYTES);
        const float* src; bf16* dst; int K, Nsrc, Ndst, kind = 0, ldw = 0; const float* gain = nullptr; bool f16 = true;
        if (r < I_FFIN) { src = ap->in[I_FFA_WIN] + (size_t)l * D * 2 * DFF; dst = wl + WO_FFA_IN; K = D; Nsrc = 2 * DFF; Ndst = 2 * DFF; kind = 1; gain = ap->in[I_NORM_FFA] + l * D; }
        else if ((r -= I_FFIN) < I_FFOUT) { src = ap->in[I_FFA_WOUT] + (size_t)l * DFF * D; dst = wl + WO_FFA_OUT; K = DFF; Nsrc = D; Ndst = D; }
        else if ((r -= I_FFOUT) < I_WINP) { src = ap->in[I_WIN] + (size_t)l * D * 8900; dst = wl + WO_WIN; K = D; Nsrc = 8900; Ndst = NPROJ; kind = 2; gain = ap->in[I_NORM_MIX] + l * D; }
        else if ((r -= I_WINP) < I_PR) { src = ap->in[I_PRET] + (size_t)l * 1024 * D; dst = wl + WO_PRET; K = 1024; Nsrc = D; Ndst = D; }
        else if ((r -= I_PR) < I_PD) { src = ap->in[I_PDSA] + (size_t)l * 512 * D; dst = wl + WO_PDR; K = 512; Nsrc = D; Ndst = D; ldw = 1024; }
        else if ((r -= I_PD) < I_PD) { src = ap->in[I_PRWKV] + (size_t)l * 512 * D; dst = wl + WO_PDR + 512; K = 512; Nsrc = D; Ndst = D; ldw = 1024; }
        else if ((r -= I_PD) < I_WO) { src = ap->in[I_WOUT] + (size_t)l * D * D; dst = wl + WO_WOUT; K = D; Nsrc = D; Ndst = D; }
        else if ((r -= I_WO) < I_FFIN) { src = ap->in[I_FFB_WIN] + (size_t)l * D * 2 * DFF; dst = wl + WO_FFB_IN; K = D; Nsrc = 2 * DFF; Ndst = 2 * DFF; kind = 1; gain = ap->in[I_NORM_FFB] + l * D; }
        else if ((r -= I_FFIN) < I_FFOUT) { src = ap->in[I_FFB_WOUT] + (size_t)l * DFF * D; dst = wl + WO_FFB_OUT; K = DFF; Nsrc = D; Ndst = D; }
        else if ((r -= I_FFOUT) < I_L64) { src = ap->in[I_W2] + (size_t)l * 64 * 512; dst = wl + WO_W2T; K = 64; Nsrc = 512; Ndst = 512; f16 = false; }
        else if ((r -= I_L64) < I_L64) { src = ap->in[I_A2] + (size_t)l * 64 * 512; dst = wl + WO_A2T; K = 64; Nsrc = 512; Ndst = 512; f16 = false; }
        else { r -= I_L64; src = ap->in[I_G2] + (size_t)l * 128 * 512; dst = wl + WO_G2T; K = 128; Nsrc = 512; Ndst = 512; f16 = false; }
        cvt_item(src, K, Nsrc, dst, ldw ? ldw : K, kind, gain, scr, r, Ndst / 32, C.lane, f16);
    }
    {
        float* tab = (float*)(ws + WS_TAB);
        const int gt = C.blk * 512 + C.tid, NT = C.G * 512;
        for (int i = gt; i < T * 40; i += NT) {
            const int t = i / 40, j = i % 40; float c, s;
            if (j < 32) { sincos_d((float)t * ap->inv_ret[j], c, s); tab[TAB_RCOS / 4 + t * 32 + j] = c; tab[TAB_RSIN / 4 + t * 32 + j] = s; }
            else { sincos_d((float)t * ap->inv_rot[j - 32], c, s); tab[TAB_PCOS / 4 + t * 8 + (j - 32)] = c; tab[TAB_PSIN / 4 + t * 8 + (j - 32)] = s; }
        }
    }
    {
        const float* x = ap->in[I_X]; bf16* xb = (bf16*)(ws + WS_XB); float* ss = (float*)(ws + WS_SS);
        for (int m0 = gw; m0 < M; m0 += 4 * NGW) {
            f32x4 v[4][4];
#pragma unroll
            for (int r = 0; r < 4; ++r) { const int m = m0 + r * NGW; const f32x4* xr = (const f32x4*)(x + (size_t)(m < M ? m : m0) * D) + C.lane;
#pragma unroll
                for (int j = 0; j < 4; ++j) v[r][j] = xr[64 * j]; }
#pragma unroll
            for (int r = 0; r < 4; ++r) { const int m = m0 + r * NGW; if (m < M) { u32x2* o = (u32x2*)(xb + (size_t)m * D) + C.lane; float s = 0.f;
#pragma unroll
                for (int j = 0; j < 4; ++j) { const f32x4 t = v[r][j]; s += (t[0] * t[0] + t[1] * t[1]) + (t[2] * t[2] + t[3] * t[3]); u32x2 w; w.x = pkh2(t[0], t[1]); w.y = pkh2(t[2], t[3]); o[64 * j] = w; }
                s = wave_sum(s);
                if (C.lane < 16) ss[(size_t)m * 16 + C.lane] = (C.lane == 0) ? s : 0.f; } }
        }
    }
}

template <int NH, bool SCALE> DI void stage_rope16(ldsp dst, int dstride, const bf16* src, int src_stride, int nrows, int pos0, const float* pcos, const float* psin, float scale, int tid) {
    const int ntask = nrows * NH * 7;
    for (int task = tid; task < ntask; task += 512) {
        const int c = task % 7, rh = task / 7, hh = rh % NH, r = rh / NH;
        const bf16* s = src + (size_t)r * src_stride + hh * 64; ldsp d = dst + r * dstride + hh * 128;
        if (c == 0) {
            const u32x4 xa = *(const u32x4*)s, xb = *(const u32x4*)(s + 8);
            const f32x4 c0 = *(const f32x4*)(pcos + (size_t)(pos0 + r) * 8), c1 = *(const f32x4*)(pcos + (size_t)(pos0 + r) * 8 + 4);
            const f32x4 s0 = *(const f32x4*)(psin + (size_t)(pos0 + r) * 8), s1 = *(const f32x4*)(psin + (size_t)(pos0 + r) * 8 + 4);
            const float cc[8] = {c0[0], c0[1], c0[2], c0[3], c1[0], c1[1], c1[2], c1[3]}; const float sn[8] = {s0[0], s0[1], s0[2], s0[3], s1[0], s1[1], s1[2], s1[3]};
            u32x4 oa, ob;
#pragma unroll
            for (int e = 0; e < 4; ++e) { const float a0 = lo_f(xa[e]), a1 = hi_f(xa[e]), b0 = lo_f(xb[e]), b1 = hi_f(xb[e]);
                float o10 = a0 * cc[2 * e] - b0 * sn[2 * e], o11 = a1 * cc[2 * e + 1] - b1 * sn[2 * e + 1], o20 = a0 * sn[2 * e] + b0 * cc[2 * e], o21 = a1 * sn[2 * e + 1] + b1 * cc[2 * e + 1];
                if (SCALE) { o10 *= scale; o11 *= scale; o20 *= scale; o21 *= scale; }
                oa[e] = pk2(o10, o11); ob[e] = pk2(o20, o21); }
            *(LAS u32x4*)d = oa; *(LAS u32x4*)(d + 16) = ob;
        } else {
            u32x4 x = *(const u32x4*)(s + 8 * (c + 1));
            if (SCALE) {
#pragma unroll
                for (int e = 0; e < 4; ++e) x[e] = pk2(lo_f(x[e]) * scale, hi_f(x[e]) * scale); }
            *(LAS u32x4*)(d + 16 * (c + 1)) = x;
        }
    }
}

struct RwkvP { const float *mu, *w0, *a0, *k_k, *k_a, *r_k; const bf16 *w2t, *a2t, *g2t; };
DI void rwkv_prep_item(const Ctx& C, const RwkvP& P, int item) {
    unsigned char* const ws = kargs()->ws;
    const bf16* proj = (const bf16*)(ws + WS_PROJ);
    const int tok0 = item * 16; const bool first = (tok0 % T) == 0;
    ldsp AL = C.lds;
    LAS float* LO = (LAS float*)(C.lds + 16384);
    constexpr int AST = 528, LOS = 1540;
    __syncthreads();
    {
        const int tk = C.tid >> 5, c8 = (C.tid & 31) * 8; const bf16* cur = proj + (size_t)(tok0 + tk) * NPROJ + C_RW + 1536 + c8;
        const u32x4 xc = *(const u32x4*)cur; u32x4 xp = {0u, 0u, 0u, 0u}; if (!(first && tk == 0)) xp = *(const u32x4*)(cur - NPROJ);
        u32x4 o;
#pragma unroll
        for (int e = 0; e < 4; ++e) { float v[2];
#pragma unroll
            for (int q = 0; q < 2; ++q) { const int col = c8 + 2 * e + q; const float c_ = q ? hi_f(xc[e]) : lo_f(xc[e]), p_ = q ? hi_f(xp[e]) : lo_f(xp[e]);
                float s = c_ + P.mu[1536 + col] * (p_ - c_);
                if (col < 64) s = tanhf_(s); else if (col >= 128) s = sigmoidf_(s);
                v[q] = s; }
            o[e] = pk2(v[0], v[1]); }
        *(LAS u32x4*)(AL + tk * AST + c8 * 2) = o;
    }
    __syncthreads();
    {
        const int fr = C.lane & 15, fq = C.lane >> 4;
#pragma unroll
        for (int seg = 0; seg < 3; ++seg) {
            const bf16* Bt = seg == 0 ? P.w2t : seg == 1 ? P.a2t : P.g2t; const int KS = seg == 2 ? 4 : 2, kbase = seg == 0 ? 0 : seg == 1 ? 64 : 128, ldb = seg == 2 ? 128 : 64;
#pragma unroll
            for (int ct = 0; ct < 4; ++ct) { f32x4 acc = {0.f, 0.f, 0.f, 0.f}; const int n = 64 * C.wave + 16 * ct + fr;
#pragma unroll
                for (int s = 0; s < 4; ++s) if (s < KS) { const bf16x8 af = lds_frag(AL + fr * AST + (kbase + 32 * s + 8 * fq) * 2); const bf16x8 bfr = *(const bf16x8*)(Bt + (size_t)n * ldb + 32 * s + 8 * fq);
                    acc = MFMA16(af, bfr, acc); }
#pragma unroll
                for (int j = 0; j < 4; ++j) LO[(4 * fq + j) * LOS + seg * 512 + n] = acc[j]; }
        }
    }
    __syncthreads();
    {
        const int col = C.tid, hh = C.wave;
        const float mr = P.mu[col], mk = P.mu[512 + col], mv = P.mu[1024 + col], w0 = P.w0[col], a0 = P.a0[col], kkc = P.k_k[col], kac = P.k_a[col], rkc = P.r_k[col];
        bf16* Pr = (bf16*)(ws + WS_PR); bf16* Pk = (bf16*)(ws + WS_PK); bf16* Pv = (bf16*)(ws + WS_PV); bf16* Pkk = (bf16*)(ws + WS_PKK); bf16* Pb = (bf16*)(ws + WS_PB);
        float* Pw = (float*)(ws + WS_PW); bf16* Pg = (bf16*)(ws + WS_PG); float* Pc = (float*)(ws + WS_PC);
        float pr = 0.f, pk = 0.f, pv = 0.f;
        if (!first) { const bf16* pp = proj + (size_t)(tok0 - 1) * NPROJ + C_RW + col; pr = bf2f(pp[0]); pk = bf2f(pp[512]); pv = bf2f(pp[1024]); }
#pragma unroll 2
        for (int tk = 0; tk < 16; ++tk) {
            const bf16* cp = proj + (size_t)(tok0 + tk) * NPROJ + C_RW + col; const float cr = bf2f(cp[0]), ck = bf2f(cp[512]), cv = bf2f(cp[1024]);
            const float rs = cr + mr * (pr - cr), ks = ck + mk * (pk - ck), vs = cv + mv * (pv - cv); pr = cr; pk = ck; pv = cv;
            const float dw = LO[tk * LOS + col], da = LO[tk * LOS + 512 + col], dg = LO[tk * LOS + 1024 + col];
            const float z = w0 + dw; const float sp = fmaxf(-z, 0.f) + __logf(1.f + __expf(-fabsf(z)));
            const float e = __expf(-sp - 0.5f); const float wdec = -e;
            const float eta = sigmoidf_(a0 + da);
            const float kkr = ks * kkc; const float n2 = wave_sum(kkr * kkr); const float kk = kkr * __builtin_amdgcn_rsqf(fmaxf(n2, 1e-24f));
            const float kp = ks * (1.f + (eta - 1.f) * kac); const float bb = kk * eta;
            const float cb = wave_sum(rs * kp * rkc);
            const size_t o = (size_t)(tok0 + tk) * 512 + col;
            Pr[o] = f2bf(rs); Pk[o] = f2bf(kp); Pv[o] = f2bf(vs); Pkk[o] = f2bf(kk); Pb[o] = f2bf(bb); Pw[o] = wdec; Pg[o] = f2bf(dg);
            if (C.lane == 0) Pc[(size_t)(tok0 + tk) * 8 + hh] = cb;
        }
    }
}

constexpr int IMS = 144, IMB = 64 * IMS;
template <bool SWAP> DI f32x4 mm16(ldsp X, int tx, ldsp Y, int ty, f32x4 acc, int fr, int fq) {
#pragma unroll
    for (int s = 0; s < 2; ++s) { const bf16x8 xf = lds_frag(X + (16 * tx + fr) * IMS + (32 * s + 8 * fq) * 2), yf = lds_frag(Y + (16 * ty + fr) * IMS + (32 * s + 8 * fq) * 2);
        acc = SWAP ? MFMA16(yf, xf, acc) : MFMA16(xf, yf, acc); }
    return acc;
}
DI void st_tile(ldsp img, int row, int col4, f32x4 v) { u32x2 w; w.x = pk2(v[0], v[1]); w.y = pk2(v[2], v[3]); *(LAS u32x2*)(img + row * IMS + col4 * 2) = w; }
DI f32x4 ld_tile(ldsp img, int row, int col4) { const u32x2 w = *(const LAS u32x2*)(img + row * IMS + col4 * 2); return (f32x4){lo_f(w.x), hi_f(w.x), lo_f(w.y), hi_f(w.y)}; }
DI void rwkv_pre_item(const Ctx& C, const RwkvP& P, int item) {
    unsigned char* const ws = kargs()->ws;
    const int chain = item / NRCH, c0 = (item % NRCH) * 64, bbh = chain >> 3, hh = chain & 7;
    const bf16* proj = (const bf16*)(ws + WS_PROJ);
    bf16* Pv = (bf16*)(ws + WS_PV); bf16* Pg = (bf16*)(ws + WS_PG); float* Pc = (float*)(ws + WS_PC);
    bf16* gG = (bf16*)(ws + WS_RG) + (size_t)item * 4096; bf16* gRP = (bf16*)(ws + WS_RRP) + (size_t)item * 4096; bf16* gH = (bf16*)(ws + WS_RH) + (size_t)item * 4096; float* gY0 = (float*)(ws + WS_RY0) + (size_t)item * 4096;
    ldsp L0 = C.lds;
    ldsp iAt = L0, iRt = L0 + IMB, iBt = L0 + 2 * IMB, iKt = L0 + 3 * IMB, iBpT = L0 + 4 * IMB, iKpT = L0 + 5 * IMB, iVT = L0 + 6 * IMB, iAtT = L0 + 7 * IMB,
         iAak = L0 + 8 * IMB, iArb = L0 + 9 * IMB, iArk = L0 + 10 * IMB, iX0 = L0 + 11 * IMB, iX1 = L0 + 12 * IMB, iX2 = L0 + 13 * IMB, iX3 = L0 + 14 * IMB;
    LAS float* SEG = (LAS float*)(L0 + 159744);
    const int fr = C.lane & 15, fq = C.lane >> 4, ti = C.wave >> 1, tj0 = 2 * (C.wave & 1);
    const size_t row0 = (size_t)bbh * T;
    ldsp iLw = L0, iLa = L0 + IMB, iLg0 = L0 + 2 * IMB, iLg1 = L0 + 3 * IMB, iW2 = L0 + 4 * IMB, iA2 = L0 + 5 * IMB, iG2a = L0 + 6 * IMB, iG2b = L0 + 7 * IMB;
    LAS float* LOw = (LAS float*)(L0 + 8 * IMB); LAS float* LOa = LOw + 64 * 68;
    ldsp LOgb = L0 + 8 * IMB + 2 * 17408, vvS = LOgb + IMB;
    LAS float* kvF = (LAS float*)(vvS + IMB); LAS float* rvF = kvF + 64 * 64;
    __syncthreads();
    {
        {
            const int t = C.tid >> 3, c8 = (C.tid & 7) * 8; const size_t tok = row0 + c0 + t; const bool nop = (c0 == 0 && t == 0);
            const bf16* pc = proj + tok * NPROJ + C_RW;
            const int off[7] = {hh * 64 + c8, 512 + hh * 64 + c8, 1024 + hh * 64 + c8, 1536 + c8, 1600 + c8, 1664 + c8, 1728 + c8};
            u32x4 cu[7], pv[7];
#pragma unroll
            for (int f = 0; f < 7; ++f) { cu[f] = *(const u32x4*)(pc + off[f]); pv[f] = (u32x4){0u, 0u, 0u, 0u}; if (!nop) pv[f] = *(const u32x4*)(pc - NPROJ + off[f]); }
            float sv[7][8];
#pragma unroll
            for (int f = 0; f < 7; ++f) { const f32x4 m0 = *(const f32x4*)(P.mu + off[f]), m1 = *(const f32x4*)(P.mu + off[f] + 4); const float mm[8] = {m0[0], m0[1], m0[2], m0[3], m1[0], m1[1], m1[2], m1[3]};
#pragma unroll
                for (int e = 0; e < 4; ++e) { const float c_lo = lo_f(cu[f][e]), c_hi = hi_f(cu[f][e]), p_lo = lo_f(pv[f][e]), p_hi = hi_f(pv[f][e]);
                    sv[f][2 * e] = c_lo + mm[2 * e] * (p_lo - c_lo); sv[f][2 * e + 1] = c_hi + mm[2 * e + 1] * (p_hi - c_hi); } }
            const int sw = (((c8 >> 3) ^ (t & 7)) << 3);
            *(LAS f32x4*)(rvF + t * 64 + sw) = (f32x4){sv[0][0], sv[0][1], sv[0][2], sv[0][3]}; *(LAS f32x4*)(rvF + t * 64 + sw + 4) = (f32x4){sv[0][4], sv[0][5], sv[0][6], sv[0][7]};
            *(LAS f32x4*)(kvF + t * 64 + sw) = (f32x4){sv[1][0], sv[1][1], sv[1][2], sv[1][3]}; *(LAS f32x4*)(kvF + t * 64 + sw + 4) = (f32x4){sv[1][4], sv[1][5], sv[1][6], sv[1][7]};
            { u32x4 w; w.x = pk2(sv[2][0], sv[2][1]); w.y = pk2(sv[2][2], sv[2][3]); w.z = pk2(sv[2][4], sv[2][5]); w.w = pk2(sv[2][6], sv[2][7]);
              *(LAS u32x4*)(vvS + t * IMS + c8 * 2) = w; *(u32x4*)(Pv + tok * 512 + hh * 64 + c8) = w; }
            { u32x4 w; w.x = pk2(tanhf_(sv[3][0]), tanhf_(sv[3][1])); w.y = pk2(tanhf_(sv[3][2]), tanhf_(sv[3][3])); w.z = pk2(tanhf_(sv[3][4]), tanhf_(sv[3][5])); w.w = pk2(tanhf_(sv[3][6]), tanhf_(sv[3][7])); *(LAS u32x4*)(iLw + t * IMS + c8 * 2) = w; }
            { u32x4 w; w.x = pk2(sv[4][0], sv[4][1]); w.y = pk2(sv[4][2], sv[4][3]); w.z = pk2(sv[4][4], sv[4][5]); w.w = pk2(sv[4][6], sv[4][7]); *(LAS u32x4*)(iLa + t * IMS + c8 * 2) = w; }
            { u32x4 w; w.x = pk2(sigmoidf_(sv[5][0]), sigmoidf_(sv[5][1])); w.y = pk2(sigmoidf_(sv[5][2]), sigmoidf_(sv[5][3])); w.z = pk2(sigmoidf_(sv[5][4]), sigmoidf_(sv[5][5])); w.w = pk2(sigmoidf_(sv[5][6]), sigmoidf_(sv[5][7])); *(LAS u32x4*)(iLg0 + t * IMS + c8 * 2) = w; }
            { u32x4 w; w.x = pk2(sigmoidf_(sv[6][0]), sigmoidf_(sv[6][1])); w.y = pk2(sigmoidf_(sv[6][2]), sigmoidf_(sv[6][3])); w.z = pk2(sigmoidf_(sv[6][4]), sigmoidf_(sv[6][5])); w.w = pk2(sigmoidf_(sv[6][6]), sigmoidf_(sv[6][7])); *(LAS u32x4*)(iLg1 + t * IMS + c8 * 2) = w; }
            const int wrow = C.tid >> 3, wch = (C.tid & 7) * 8;
            *(LAS u32x4*)(iW2 + wrow * IMS + wch * 2) = *(const u32x4*)(P.w2t + (size_t)(hh * 64 + wrow) * 64 + wch); *(LAS u32x4*)(iA2 + wrow * IMS + wch * 2) = *(const u32x4*)(P.a2t + (size_t)(hh * 64 + wrow) * 64 + wch);
            *(LAS u32x4*)(iG2a + wrow * IMS + wch * 2) = *(const u32x4*)(P.g2t + (size_t)(hh * 64 + wrow) * 128 + wch); *(LAS u32x4*)(iG2b + wrow * IMS + wch * 2) = *(const u32x4*)(P.g2t + (size_t)(hh * 64 + wrow) * 128 + 64 + wch);
        }
        const int k = C.tid & 63, seg = C.tid >> 6; const size_t tokb = row0 + c0 + 8 * seg;
        float lw[8], cs[8], kkv[8], bv[8], kv[8], rv[8], vv[8];
        __syncthreads();
#pragma unroll
        for (int e = 0; e < 2; ++e) { const int tj = tj0 + e; const f32x4 z = {0.f, 0.f, 0.f, 0.f}; const int rr = 16 * ti + fr, cc = 16 * tj + 4 * fq;
            *(LAS f32x4*)(LOw + rr * 68 + cc) = mm16<true>(iLw, ti, iW2, tj, z, fr, fq); *(LAS f32x4*)(LOa + rr * 68 + cc) = mm16<true>(iLa, ti, iA2, tj, z, fr, fq);
            f32x4 g = mm16<true>(iLg0, ti, iG2a, tj, z, fr, fq); g = mm16<true>(iLg1, ti, iG2b, tj, g, fr, fq); st_tile(LOgb, rr, cc, g); }
        __syncthreads();
        float run = 0.f;
        {
            { const int t = C.tid >> 3, c8 = (C.tid & 7) * 8; *(u32x4*)(Pg + (row0 + c0 + t) * 512 + hh * 64 + c8) = *(const LAS u32x4*)(LOgb + t * IMS + c8 * 2); }
            const int col = hh * 64 + k; const float w0 = P.w0[col], a0 = P.a0[col], kkc = P.k_k[col], kac = P.k_a[col], rkc = P.r_k[col];
#pragma unroll
            for (int i = 0; i < 8; ++i) { const int t = 8 * seg + i; const float dw = LOw[t * 68 + k], da = LOa[t * 68 + k];
                { const int si = t * 64 + (((k >> 3) ^ (t & 7)) << 3) + (k & 7); rv[i] = rvF[si]; kv[i] = kvF[si]; vv[i] = bf2f(*(const LAS bf16*)(vvS + t * IMS + k * 2)); }
                const float z = w0 + dw;
                lw[i] = -0.60653066f * sigmoidf_(z); run += lw[i]; cs[i] = run;
                const float eta = sigmoidf_(a0 + da);
                const float kkr = kv[i] * kkc; const float n2 = wave_sum(kkr * kkr); kkv[i] = kkr * __builtin_amdgcn_rsqf(fmaxf(n2, 1e-24f));
                kv[i] = kv[i] * (1.f + (eta - 1.f) * kac); bv[i] = kkv[i] * eta;
                const float cb = wave_sum(rv[i] * kv[i] * rkc);
                if (C.lane == 0) Pc[(tokb + i) * 8 + hh] = cb; }
        }
        __syncthreads();
        SEG[seg * 64 + k] = run;
        __syncthreads();
        float pre = 0.f, tot = 0.f;
#pragma unroll
        for (int s2 = 0; s2 < 8; ++s2) { const float x = SEG[s2 * 64 + k]; tot += x; if (s2 < seg) pre += x; }
        u32x4 wbp, wkp, wvt, wat; float bp[8], kp[8], at[8];
        const float etot = __expf(tot); float gprev = __expf(pre);
#pragma unroll
        for (int i = 0; i < 8; ++i) { const float lgi = pre + cs[i]; const float gi = __expf(lgi), gx = gprev, ginv = __builtin_amdgcn_rcpf(gi), gc = etot * ginv;
            gprev = gi;
            const int t = 8 * seg + i; at[i] = -kkv[i] * gx;
            *(LAS bf16*)(iAt + t * IMS + k * 2) = f2bf(at[i]); *(LAS bf16*)(iRt + t * IMS + k * 2) = f2bf(rv[i] * gi);
            *(LAS bf16*)(iBt + t * IMS + k * 2) = f2bf(bv[i] * ginv); *(LAS bf16*)(iKt + t * IMS + k * 2) = f2bf(kv[i] * ginv);
            bp[i] = bv[i] * gc; kp[i] = kv[i] * gc; }
#pragma unroll
        for (int e = 0; e < 4; ++e) { wbp[e] = pk2(bp[2 * e], bp[2 * e + 1]); wkp[e] = pk2(kp[2 * e], kp[2 * e + 1]); wvt[e] = pk2(vv[2 * e], vv[2 * e + 1]); wat[e] = pk2(at[2 * e], at[2 * e + 1]); }
        *(LAS u32x4*)(iBpT + k * IMS + 16 * seg) = wbp; *(LAS u32x4*)(iKpT + k * IMS + 16 * seg) = wkp; *(LAS u32x4*)(iVT + k * IMS + 16 * seg) = wvt; *(LAS u32x4*)(iAtT + k * IMS + 16 * seg) = wat;
        if (seg == 0) SEG[512 + k] = etot;
    }
    __syncthreads();
    {
#pragma unroll
        for (int e = 0; e < 2; ++e) { const int tj = tj0 + e; const f32x4 z = {0.f, 0.f, 0.f, 0.f};
            f32x4 lab = mm16<true>(iAt, ti, iBt, tj, z, fr, fq), lak = mm16<true>(iAt, ti, iKt, tj, z, fr, fq), lrb = mm16<true>(iRt, ti, iBt, tj, z, fr, fq), lrk = mm16<true>(iRt, ti, iKt, tj, z, fr, fq);
            f32x4 labT = mm16<false>(iAt, ti, iBt, tj, z, fr, fq);
            const int t = 16 * ti + fr; f32x4 m1;
#pragma unroll
            for (int i = 0; i < 4; ++i) { const int j = 16 * tj + 4 * fq + i; if (!(j < t)) { lab[i] = 0.f; lak[i] = 0.f; } if (!(j <= t)) { lrb[i] = 0.f; lrk[i] = 0.f; } m1[i] = lab[i] + ((j == t) ? 1.f : 0.f); }
#pragma unroll
            for (int i = 0; i < 4; ++i) { const int tt = 16 * ti + 4 * fq + i, jj = 16 * tj + fr; if (!(jj < tt)) labT[i] = 0.f; }
            st_tile(iX0, t, 16 * tj + 4 * fq, lab); st_tile(iX1, 16 * tj + fr, 16 * ti + 4 * fq, labT); st_tile(iX2, t, 16 * tj + 4 * fq, m1);
            st_tile(iAak, t, 16 * tj + 4 * fq, lak); st_tile(iArb, t, 16 * tj + 4 * fq, lrb); st_tile(iArk, t, 16 * tj + 4 * fq, lrk); }
    }
    __syncthreads();
    ldsp Pn = iX0, Pt = iX1, Qn = iBt, Qt = iKt, Mc = iX2, Mn = iX3;
#pragma unroll 1
    for (int lev = 0; lev < 6; ++lev) {
#pragma unroll
        for (int e = 0; e < 2; ++e) { const int tj = tj0 + e; const f32x4 z = {0.f, 0.f, 0.f, 0.f};
            if (lev < 5) { const f32x4 q = mm16<true>(Pn, ti, Pt, tj, z, fr, fq), qT = mm16<false>(Pn, ti, Pt, tj, z, fr, fq);
                st_tile(Qn, 16 * ti + fr, 16 * tj + 4 * fq, q); st_tile(Qt, 16 * tj + fr, 16 * ti + 4 * fq, qT); }
            if (lev > 0) { f32x4 m = mm16<true>(Mc, ti, Pt, tj, z, fr, fq); m += ld_tile(Mc, 16 * ti + fr, 16 * tj + 4 * fq); st_tile(Mn, 16 * ti + fr, 16 * tj + 4 * fq, m); } }
        __syncthreads();
        if (lev > 0) { ldsp x = Mc; Mc = Mn; Mn = x; }
        if (lev < 5) { ldsp x = Pn; Pn = Qn; Qn = x; x = Pt; Pt = Qt; Qt = x; }
    }
    ldsp iPT = Mn, iWT = Qn, iQT = Qt;
#pragma unroll
    for (int e = 0; e < 2; ++e) { const int tj = tj0 + e; const f32x4 z = {0.f, 0.f, 0.f, 0.f};
        st_tile(iPT, 16 * ti + fr, 16 * tj + 4 * fq, mm16<true>(iAtT, ti, Mc, tj, z, fr, fq));
        st_tile(iWT, 16 * ti + fr, 16 * tj + 4 * fq, mm16<true>(iVT, ti, iAak, tj, z, fr, fq)); }
    __syncthreads();
#pragma unroll
    for (int e = 0; e < 2; ++e) { const int tj = tj0 + e; const f32x4 z = {0.f, 0.f, 0.f, 0.f}; const int rr = 16 * ti + fr, cc = 16 * tj + 4 * fq;
        st_tile(iQT, rr, cc, mm16<true>(iWT, ti, Mc, tj, z, fr, fq));
        f32x4 rp = mm16<true>(iArb, ti, iPT, tj, z, fr, fq); rp += ld_tile(iRt, rr, cc);
        { u32x2 w; w.x = pk2(rp[0], rp[1]); w.y = pk2(rp[2], rp[3]); *(u32x2*)(gRP + rr * 64 + cc) = w; }
        f32x4 g = mm16<true>(iBpT, ti, iPT, tj, z, fr, fq);
#pragma unroll
        for (int i = 0; i < 4; ++i) if (cc + i == rr) g[i] += SEG[512 + rr];
        { u32x2 w; w.x = pk2(g[0], g[1]); w.y = pk2(g[2], g[3]); *(u32x2*)(gG + rr * 64 + cc) = w; } }
    __syncthreads();
#pragma unroll
    for (int e = 0; e < 2; ++e) { const int tj = tj0 + e; const int rr = 16 * ti + fr, cc = 16 * tj + 4 * fq;
        f32x4 y0 = {0.f, 0.f, 0.f, 0.f}; y0 = mm16<true>(iArb, ti, iQT, tj, y0, fr, fq); y0 = mm16<true>(iArk, ti, iVT, tj, y0, fr, fq); *(f32x4*)(gY0 + rr * 64 + cc) = y0;
        f32x4 h = {0.f, 0.f, 0.f, 0.f}; h = mm16<true>(iQT, ti, iBpT, tj, h, fr, fq); h = mm16<true>(iVT, ti, iKpT, tj, h, fr, fq);
        { u32x2 w; w.x = pk2(h[0], h[1]); w.y = pk2(h[2], h[3]); *(u32x2*)(gH + rr * 64 + cc) = w; } }
}
DI void rwkv_state_chain(const Ctx& C, int chain) {
    unsigned char* const ws = kargs()->ws;
    const bf16* gG = (const bf16*)(ws + WS_RG) + (size_t)chain * NRCH * 4096; const bf16* gH = (const bf16*)(ws + WS_RH) + (size_t)chain * NRCH * 4096; bf16* gS = (bf16*)(ws + WS_RSC) + (size_t)chain * NRCH * 4096;
    ldsp iSb = C.lds, iG = C.lds + IMB;
    const int fr = C.lane & 15, fq = C.lane >> 4, ti = C.wave >> 1, tj0 = 2 * (C.wave & 1);
    f32x4 st[2] = {{0.f, 0.f, 0.f, 0.f}, {0.f, 0.f, 0.f, 0.f}};
    const int grow = C.tid >> 3, gch = (C.tid & 7) * 8;
    u32x4 gpre = *(const u32x4*)(gG + grow * 64 + gch);
    u32x2 hpre[2];
#pragma unroll
    for (int e = 0; e < 2; ++e) hpre[e] = *(const u32x2*)(gH + (16 * ti + fr) * 64 + 16 * (tj0 + e) + 4 * fq);
#pragma unroll 1
    for (int c = 0; c < NRCH; ++c) {
        __syncthreads();
#pragma unroll
        for (int e = 0; e < 2; ++e) { u32x2 w; w.x = pk2(st[e][0], st[e][1]); w.y = pk2(st[e][2], st[e][3]);
            *(LAS u32x2*)(iSb + (16 * ti + fr) * IMS + (16 * (tj0 + e) + 4 * fq) * 2) = w; *(u32x2*)(gS + (size_t)c * 4096 + (16 * ti + fr) * 64 + 16 * (tj0 + e) + 4 * fq) = w; }
        if (c == NRCH - 1) break;
        *(LAS u32x4*)(iG + grow * IMS + gch * 2) = gpre;
        u32x2 hw[2];
#pragma unroll
        for (int e = 0; e < 2; ++e) hw[e] = hpre[e];
        gpre = *(const u32x4*)(gG + (size_t)(c + 1) * 4096 + grow * 64 + gch);
#pragma unroll
        for (int e = 0; e < 2; ++e) hpre[e] = *(const u32x2*)(gH + (size_t)(c + 1) * 4096 + (16 * ti + fr) * 64 + 16 * (tj0 + e) + 4 * fq);
        __syncthreads();
#pragma unroll
        for (int e = 0; e < 2; ++e) { f32x4 sn = {lo_f(hw[e].x), hi_f(hw[e].x), lo_f(hw[e].y), hi_f(hw[e].y)}; sn = mm16<true>(iSb, ti, iG, tj0 + e, sn, fr, fq); st[e] = sn; }
    }
}
struct RwkvOutPre { u32x4 rp, sc, xv, xg; f32x4 y0[2]; float cb; };
DI void rwkv_out_load(const Ctx& C, int item, RwkvOutPre& P) {
    unsigned char* const ws = kargs()->ws;
    const int chain = item / NRCH, c0 = (item % NRCH) * 64, bbh = chain >> 3, hh = chain & 7;
    const bf16* gRP = (const bf16*)(ws + WS_RRP) + (size_t)item * 4096; const bf16* gS = (const bf16*)(ws + WS_RSC) + (size_t)item * 4096; const float* gY0 = (const float*)(ws + WS_RY0) + (size_t)item * 4096;
    const bf16* Pv = (const bf16*)(ws + WS_PV); const bf16* Pg = (const bf16*)(ws + WS_PG); const float* Pc = (const float*)(ws + WS_PC);
    const int fr = C.lane & 15, fq = C.lane >> 4, ti = C.wave >> 1, tj0 = 2 * (C.wave & 1);
    const int grow = C.tid >> 3, gch = (C.tid & 7) * 8;
    P.rp = *(const u32x4*)(gRP + grow * 64 + gch); P.sc = *(const u32x4*)(gS + grow * 64 + gch);
#pragma unroll
    for (int e = 0; e < 2; ++e) P.y0[e] = *(const f32x4*)(gY0 + (16 * ti + fr) * 64 + 16 * (tj0 + e) + 4 * fq);
    const int t = C.tid >> 3, v8 = (C.tid & 7) * 8; const size_t tok = (size_t)bbh * T + c0 + t;
    P.xv = *(const u32x4*)(Pv + tok * 512 + hh * 64 + v8); P.xg = *(const u32x4*)(Pg + tok * 512 + hh * 64 + v8); P.cb = Pc[tok * 8 + hh];
}
DI void rwkv_out_items(const Ctx& C, int lo, int hi, const float* ln_w, const float* ln_b) {
    if (lo >= hi) return;
    unsigned char* const ws = kargs()->ws;
    bf16* yo = (bf16*)(ws + WS_YDR) + 512;
    ldsp iRP = C.lds, iSc = C.lds + IMB; LAS float* YL = (LAS float*)(C.lds + 2 * IMB);
    const int fr = C.lane & 15, fq = C.lane >> 4, ti = C.wave >> 1, tj0 = 2 * (C.wave & 1);
    const int grow = C.tid >> 3, gch = (C.tid & 7) * 8;
    RwkvOutPre N; rwkv_out_load(C, lo, N);
#pragma unroll 1
    for (int item = lo; item < hi; ++item) {
        const int chain = item / NRCH, c0 = (item % NRCH) * 64, bbh = chain >> 3, hh = chain & 7;
        const RwkvOutPre P = N;
        __syncthreads();
        *(LAS u32x4*)(iRP + grow * IMS + gch * 2) = P.rp; *(LAS u32x4*)(iSc + grow * IMS + gch * 2) = P.sc;
        if (item + 1 < hi) rwkv_out_load(C, item + 1, N);
        __syncthreads();
#pragma unroll
        for (int e = 0; e < 2; ++e) { const int tj = tj0 + e; const int rr = 16 * ti + fr, cc = 16 * tj + 4 * fq;
            f32x4 y = P.y0[e]; y = mm16<true>(iRP, ti, iSc, tj, y, fr, fq); *(LAS f32x4*)(YL + rr * 68 + cc) = y; }
        __syncthreads();
        {
            const int t = C.tid >> 3, v8 = (C.tid & 7) * 8; const size_t tok = (size_t)bbh * T + c0 + t;
            const f32x4 ya = *(const LAS f32x4*)(YL + t * 68 + v8), yb = *(const LAS f32x4*)(YL + t * 68 + v8 + 4);
            float y[8] = {ya[0], ya[1], ya[2], ya[3], yb[0], yb[1], yb[2], yb[3]};
            float sm = ((y[0] + y[1]) + (y[2] + y[3])) + ((y[4] + y[5]) + (y[6] + y[7])); sm += dppf<0xB1>(sm); sm += dppf<0x4E>(sm); sm += dppf<0x141>(sm);
            const float mean = sm * (1.f / 64.f); float sq = 0.f;
#pragma unroll
            for (int i = 0; i < 8; ++i) { y[i] -= mean; sq += y[i] * y[i]; }
            sq += dppf<0xB1>(sq); sq += dppf<0x4E>(sq); sq += dppf<0x141>(sq);
            const float rstd = __builtin_amdgcn_rsqf(sq * (1.f / 64.f) + 64e-5f);
            const u32x4 xv = P.xv, xg = P.xg; const float cb = P.cb;
            const f32x4 lw0 = *(const f32x4*)(ln_w + hh * 64 + v8), lw1 = *(const f32x4*)(ln_w + hh * 64 + v8 + 4), lb0 = *(const f32x4*)(ln_b + hh * 64 + v8), lb1 = *(const f32x4*)(ln_b + hh * 64 + v8 + 4);
            const float lw[8] = {lw0[0], lw0[1], lw0[2], lw0[3], lw1[0], lw1[1], lw1[2], lw1[3]}, lb[8] = {lb0[0], lb0[1], lb0[2], lb0[3], lb1[0], lb1[1], lb1[2], lb1[3]};
            u32x4 o;
#pragma unroll
            for (int e = 0; e < 4; ++e) { const float v0 = lo_f(xv[e]), v1 = hi_f(xv[e]), g0 = lo_f(xg[e]), g1 = hi_f(xg[e]);
                const float o0 = (y[2 * e] * rstd * lw[2 * e] + lb[2 * e] + cb * v0) * g0, o1 = (y[2 * e + 1] * rstd * lw[2 * e + 1] + lb[2 * e + 1] + cb * v1) * g1; o[e] = pkh2(o0, o1); }
            *(u32x4*)(yo + tok * 1024 + hh * 64 + v8) = o;
        }
    }
}

template <bool WANT_Q, bool WANT_K, bool WANT_KDT> DI void ret_stage(const Ctx& C, const bf16* proj, size_t row0, int ch, int hh, float lg2, const float* rcos, const float* rsin, ldsp Qs, ldsp Ks, ldsp KdT, ldsp VT) {
    constexpr int QST = 144, TST = 272;
    {
        const int i = C.tid >> 2, p0 = (C.tid & 3) * 8; const int pos = ch * 128 + i;
        const f32x4 c0 = *(const f32x4*)(rcos + pos * 32 + p0), c1 = *(const f32x4*)(rcos + pos * 32 + p0 + 4), s0 = *(const f32x4*)(rsin + pos * 32 + p0), s1 = *(const f32x4*)(rsin + pos * 32 + p0 + 4);
        const float cc[8] = {c0[0], c0[1], c0[2], c0[3], c1[0], c1[1], c1[2], c1[3]}; const float sn[8] = {s0[0], s0[1], s0[2], s0[3], s1[0], s1[1], s1[2], s1[3]};
        if (WANT_Q) { const bf16* qp = proj + (row0 + i) * NPROJ + C_RQ + hh * 64 + p0; const u32x4 qa = *(const u32x4*)qp, qb = *(const u32x4*)(qp + 32); u32x4 oqa, oqb;
#pragma unroll
            for (int e = 0; e < 4; ++e) { const float q10 = lo_f(qa[e]), q11 = hi_f(qa[e]), q20 = lo_f(qb[e]), q21 = hi_f(qb[e]);
                oqa[e] = pk2(q10 * cc[2 * e] - q20 * sn[2 * e], q11 * cc[2 * e + 1] - q21 * sn[2 * e + 1]); oqb[e] = pk2(q10 * sn[2 * e] + q20 * cc[2 * e], q11 * sn[2 * e + 1] + q21 * cc[2 * e + 1]); }
            *(LAS u32x4*)(Qs + i * QST + p0 * 2) = oqa; *(LAS u32x4*)(Qs + i * QST + (32 + p0) * 2) = oqb; }
        if (WANT_K || WANT_KDT) { const bf16* kp = proj + (row0 + i) * NPROJ + C_RK + hh * 64 + p0; const u32x4 ka = *(const u32x4*)kp, kb = *(const u32x4*)(kp + 32);
            const float kd = ex2((float)(127 - i) * lg2); u32x4 oka, okb;
#pragma unroll
            for (int e = 0; e < 4; ++e) { const float k10 = lo_f(ka[e]), k11 = hi_f(ka[e]), k20 = lo_f(kb[e]), k21 = hi_f(kb[e]);
                const float r10 = k10, r11 = k11, r20 = k20, r21 = k21;
                oka[e] = pk2(r10, r11); okb[e] = pk2(r20, r21);
                if (WANT_KDT) { *(LAS bf16*)(KdT + (p0 + 2 * e) * TST + i * 2) = f2bf(r10 * kd); *(LAS bf16*)(KdT + (p0 + 2 * e + 1) * TST + i * 2) = f2bf(r11 * kd);
                    *(LAS bf16*)(KdT + (32 + p0 + 2 * e) * TST + i * 2) = f2bf(r20 * kd); *(LAS bf16*)(KdT + (32 + p0 + 2 * e + 1) * TST + i * 2) = f2bf(r21 * kd); } }
            if (WANT_K) { *(LAS u32x4*)(Ks + i * QST + p0 * 2) = oka; *(LAS u32x4*)(Ks + i * QST + (32 + p0) * 2) = okb; } }
    }
}
DI void ret_state_item(const Ctx& C, int bh, int ch, const float* rcos, const float* rsin) {
    unsigned char* const ws = kargs()->ws;
    const int bbh = bh >> 3, hh = bh & 7; const bf16* proj = (const bf16*)(ws + WS_PROJ); bf16* gU = (bf16*)(ws + WS_RU) + ((size_t)bh * 16 + ch) * 8192;
    constexpr int TST = 272; ldsp KdT = C.lds, VR = KdT + 64 * TST;
    const float lg2 = ret_lg2(hh);
    const int lr = C.lane & 31, hi = C.lane >> 5, wq = C.wave >> 1, wp = C.wave & 1;
    const size_t row0 = (size_t)bbh * T + ch * 128;
    __syncthreads();
    dma_tile128b<128>(VR, proj + row0 * NPROJ + C_RV + hh * 128, NPROJ, C.wave, C.lane);
    ret_stage<false, false, true>(C, proj, row0, ch, hh, lg2, rcos, rsin, KdT, KdT, KdT, VR);
    VM_WAIT(); __syncthreads();
    f32x16 st;
#pragma unroll
    for (int r = 0; r < 16; ++r) st[r] = 0.f;
    bf16x8 vf[8]; { const unsigned vb = (unsigned)(size_t)VR; tr_frags8(vb + tr_addr0((unsigned)C.lane, (unsigned)wq, 0u), vb + tr_addr0((unsigned)C.lane, (unsigned)wq, 1u), vf); }
#pragma unroll
    for (int s = 0; s < 8; ++s) st = MFMA32(vf[s], lds_frag(KdT + (32 * wp + lr) * TST + (16 * s + 8 * hi) * 2), st);
#pragma unroll
    for (int r = 0; r < 16; ++r) gU[(32 * wq + crow(r, hi)) * 64 + 32 * wp + lr] = f2bf(st[r]);
}
#ifndef DUP_PHASE
#define DUP_PHASE -1
#endif
#define REPX(k) for (int repx = 0; repx < ((DUP_PHASE == (k)) ? 2 : 1); ++repx)
DI bf16x8 frag_sw(ldsp tile, int row, int c) { return *(const LAS bf16x8*)(tile + row * 128 + ((c ^ (row & 7)) << 4)); }
template <int ROWS> DI void dma_tile64(ldsp dst, const bf16* src, size_t src_stride, int wave, int lane) {
#pragma unroll
    for (int g0 = 0; g0 < ROWS / 8; g0 += 8) { const int g = g0 + wave; const int row = g * 8 + (lane >> 3), c = (lane & 7) ^ (row & 7);
        __builtin_amdgcn_global_load_lds((const unsigned*)(src + (size_t)row * src_stride + 8 * c), (LAS unsigned*)(dst + g * 1024), 16, 0, 0); }
}
DI void ret_prep(const Ctx& C, const float* rcos, const float* rsin) {
    unsigned char* const ws = kargs()->ws; const bf16* proj = (const bf16*)(ws + WS_PROJ);
    bf16* qr = (bf16*)(ws + WS_RQR); bf16* kr = (bf16*)(ws + WS_RKR); bf16* vT = (bf16*)(ws + WS_RVT);
    const int gw = C.blk * 8 + C.wave, NGW = C.G * 8;
    for (int wt = gw; wt < (MG / 64) * 128; wt += NGW) { const int tok = (wt >> 7) * 64 + C.lane, hd = wt & 127, hh = hd >> 4, dc = hd & 15, bb = tok / T, pos = tok % T;
        const u32x4 xv = *(const u32x4*)(proj + (size_t)tok * NPROJ + C_RV + hh * 128 + 8 * dc);
#pragma unroll
        for (int e = 0; e < 4; ++e) { vT[((size_t)(bb * 8 + hh) * 128 + 8 * dc + 2 * e) * T + pos] = (bf16)(xv[e] & 0xffffu); vT[((size_t)(bb * 8 + hh) * 128 + 8 * dc + 2 * e + 1) * T + pos] = (bf16)(xv[e] >> 16); } }
}
template <int ROWS> DI void dma_tile128(ldsp dst, const bf16* src, size_t src_stride, int wave, int lane) {
#pragma unroll
    for (int g0 = 0; g0 < ROWS / 4; g0 += 8) { const int g = g0 + wave; const int row = g * 4 + (lane >> 4), c = (lane & 15) ^ (row & 7);
        __builtin_amdgcn_global_load_lds((const unsigned*)(src + (size_t)row * src_stride + 8 * c), (LAS unsigned*)(dst + g * 1024), 16, 0, 0); }
}
DI bf16x8 frag128(ldsp tile, int row, int c) { return *(const LAS bf16x8*)(tile + row * 256 + ((c ^ (row & 7)) << 4)); }

DI void ret_scan(const Ctx& C) {
    unsigned char* const ws = kargs()->ws;
    if (C.tid >= 128) return;
    const int e = C.blk + C.G * C.tid;
    if (e >= BG * 8 * 1024) return;
    const int bh = e >> 10, off = (e & 1023) * 8; const float g128 = ex2(128.f * ret_lg2(bh & 7));
    const bf16* gU = (const bf16*)(ws + WS_RU) + (size_t)bh * 16 * 8192 + off; bf16* gS = (bf16*)(ws + WS_RS) + (size_t)bh * 16 * 8192 + off;
    u32x4 uv[15];
#pragma unroll
    for (int c = 0; c < 15; ++c) uv[c] = *(const u32x4*)(gU + (size_t)c * 8192);
    float st[8];
#pragma unroll
    for (int k = 0; k < 8; ++k) st[k] = 0.f;
#pragma unroll
    for (int c = 0; c < 15; ++c) { u32x4 o;
#pragma unroll
        for (int k = 0; k < 4; ++k) { st[2 * k] = g128 * st[2 * k] + lo_f(uv[c][k]); st[2 * k + 1] = g128 * st[2 * k + 1] + hi_f(uv[c][k]); o[k] = pk2(st[2 * k], st[2 * k + 1]); }
        *(u32x4*)(gS + (size_t)(c + 1) * 8192) = o; }
}
DI void ret_out_stage(const Ctx& C, int bh, int ch, ldsp Qs, ldsp Ks, ldsp VT, u32x4& sa, u32x4& sb) {
    unsigned char* const ws = kargs()->ws;
    const bf16* qr = (const bf16*)(ws + WS_RQR); const bf16* kr = (const bf16*)(ws + WS_RKR); const bf16* vT = (const bf16*)(ws + WS_RVT);
    const int bbh = bh >> 3, hh = bh & 7; const size_t row0 = (size_t)bbh * T + ch * 128;
    { const bf16* pj = (const bf16*)(ws + WS_PROJ); dma_tile64<128>(Qs, pj + row0 * NPROJ + C_RQ + hh * 64, NPROJ, C.wave, C.lane); dma_tile64<128>(Ks, pj + row0 * NPROJ + C_RK + hh * 64, NPROJ, C.wave, C.lane); }
    dma_tile128b<128>(VT, (const bf16*)(ws + WS_PROJ) + row0 * NPROJ + C_RV + hh * 128, NPROJ, C.wave, C.lane);
    const int dv = C.tid >> 2, dk0 = (C.tid & 3) * 16; sa = (u32x4){0u, 0u, 0u, 0u}; sb = (u32x4){0u, 0u, 0u, 0u};
    if (ch > 0) { const bf16* gS = (const bf16*)(ws + WS_RS) + ((size_t)bh * 16 + ch) * 8192 + dv * 64 + dk0; sa = *(const u32x4*)gS; sb = *(const u32x4*)(gS + 8); }
}
DI void ret_out_items(const Ctx& C, int lo, int hi) {
    if (lo >= hi) return;
    unsigned char* const ws = kargs()->ws;
    const bf16* proj = (const bf16*)(ws + WS_PROJ); bf16* yret = (bf16*)(ws + WS_YRET);
    constexpr int PST = 272, SST = 144;
    ldsp Qs = C.lds, Ks = Qs + 16384, VT = Ks + 16384, Ps = VT + 32768, STb = Ps + 128 * PST; LAS float* SSQ = (LAS float*)(STb + 128 * SST);
    const int lr = C.lane & 31, hi5 = C.lane >> 5, wq = C.wave >> 1, wp = C.wave & 1;
    const int i = 32 * wq + lr;
    const int sdv = C.tid >> 2, sdk0 = (C.tid & 3) * 16;
    u32x4 sa, sb;
    __syncthreads();
    ret_out_stage(C, lo % (BG * 8), lo / (BG * 8), Qs, Ks, VT, sa, sb);
#pragma unroll 1
    for (int item = lo; item < hi; ++item) {
        const int bh = item % (BG * 8), ch = item / (BG * 8), bbh = bh >> 3, hh = bh & 7;
        const float lg2 = ret_lg2(hh);
        const size_t row0 = (size_t)bbh * T + ch * 128;
        *(LAS u32x4*)(STb + sdv * SST + sdk0 * 2) = sa; *(LAS u32x4*)(STb + sdv * SST + sdk0 * 2 + 16) = sb;
        VM_WAIT(); __syncthreads();
        u32x2 gwv[2][4];
#pragma unroll
        for (int dd = 0; dd < 2; ++dd)
#pragma unroll
            for (int g = 0; g < 4; ++g) gwv[dd][g] = *(const u32x2*)(proj + (row0 + i) * NPROJ + C_RG + hh * 128 + 32 * (2 * wp + dd) + 8 * g + 4 * hi5);
        const float ei = ex2((float)i * lg2);
        {
#pragma unroll 1
            for (int jj = 0; jj < 2; ++jj) { const int jt = 2 * wp + jj; f32x16 acc;
#pragma unroll
                for (int r = 0; r < 16; ++r) acc[r] = 0.f;
#pragma unroll
                for (int s = 0; s < 4; ++s) acc = MFMA32(frag_sw(Ks, 32 * jt + lr, 2 * s + hi5), frag_sw(Qs, 32 * wq + lr, 2 * s + hi5), acc);
#pragma unroll
                for (int g = 0; g < 4; ++g) { float pv[4];
#pragma unroll
                    for (int e = 0; e < 4; ++e) { const int j = 32 * jt + 8 * g + 4 * hi5 + e; pv[e] = (i >= j) ? acc[4 * g + e] * ei * ex2(-(float)j * lg2) : 0.f; }
                    u32x2 w; w.x = pk2(pv[0], pv[1]); w.y = pk2(pv[2], pv[3]); *(LAS u32x2*)(Ps + i * PST + (32 * jt + 8 * g + 4 * hi5) * 2) = w; } }
        }
        __syncthreads();
        f32x16 o[2];
        {
            const float qd = ex2((float)(i + 1) * lg2);
#pragma unroll
            for (int dd = 0; dd < 2; ++dd) { const int dt = 2 * wp + dd; f32x16 a1, a2;
#pragma unroll
                for (int r = 0; r < 16; ++r) { a1[r] = 0.f; a2[r] = 0.f; }
                bf16x8 vf[8]; { const unsigned vb = (unsigned)(size_t)VT; tr_frags8(vb + tr_addr0((unsigned)C.lane, (unsigned)dt, 0u), vb + tr_addr0((unsigned)C.lane, (unsigned)dt, 1u), vf); }
#pragma unroll
                for (int s = 0; s < 8; ++s) a1 = MFMA32(vf[s], lds_frag(Ps + (32 * wq + lr) * PST + (16 * s + 8 * hi5) * 2), a1);
#pragma unroll
                for (int s = 0; s < 4; ++s) a2 = MFMA32(lds_frag(STb + (32 * dt + lr) * SST + (16 * s + 8 * hi5) * 2), frag_sw(Qs, 32 * wq + lr, 2 * s + hi5), a2);
#pragma unroll
                for (int r = 0; r < 16; ++r) o[dd][r] = a1[r] + qd * a2[r]; }
            float sq = 0.f;
#pragma unroll
            for (int r = 0; r < 16; ++r) sq += o[0][r] * o[0][r] + o[1][r] * o[1][r];
            sq = swap32_sum(sq);
            if (hi5 == 0) SSQ[i * 2 + wp] = sq;
        }
        __syncthreads();
        if (item + 1 < hi) ret_out_stage(C, (item + 1) % (BG * 8), (item + 1) / (BG * 8), Qs, Ks, VT, sa, sb);
        {
            const float rn = __builtin_amdgcn_rsqf((SSQ[i * 2] + SSQ[i * 2 + 1]) * (1.f / 128.f) + RMS_EPS);
#pragma unroll
            for (int dd = 0; dd < 2; ++dd)
#pragma unroll
                for (int g = 0; g < 4; ++g) { const int dv = 32 * (2 * wp + dd) + 8 * g + 4 * hi5;
                    const u32x2 gw = gwv[dd][g];
                    u32x2 w; w.x = pkh2(siluf_(lo_f(gw.x)) * o[dd][4 * g] * rn, siluf_(hi_f(gw.x)) * o[dd][4 * g + 1] * rn); w.y = pkh2(siluf_(lo_f(gw.y)) * o[dd][4 * g + 2] * rn, siluf_(hi_f(gw.y)) * o[dd][4 * g + 3] * rn);
                    *(u32x2*)(yret + (row0 + i) * 1024 + hh * 128 + dv) = w; }
        }
    }
}

constexpr float DSA_QSCALE = 0.125f * 1.4426950408889634f;
DI void dsa_prep(const Ctx& C, const float* pcos, const float* psin) {
    unsigned char* const ws = kargs()->ws; bf16* proj = (bf16*)(ws + WS_PROJ); bf16* vT = (bf16*)(ws + WS_VT);
    const int gt = C.blk * 512 + C.tid, NT = C.G * 512;
    for (int task = gt; task < MG * 14; task += NT) {
        const int tok = task / 14, hb = task % 14, pos = tok % T;
        const int col = hb < 8 ? C_DQ + 64 * hb : hb == 8 ? C_DK : hb < 13 ? C_DQI + 64 * (hb - 9) : C_DKI;
        bf16* p = proj + (size_t)tok * NPROJ + col; const bool isq = hb < 8; const float sc = isq ? DSA_QSCALE : 1.f;
        const u32x4 xa = *(const u32x4*)p, xb = *(const u32x4*)(p + 8);
        const f32x4 c0 = *(const f32x4*)(pcos + (size_t)pos * 8), c1 = *(const f32x4*)(pcos + (size_t)pos * 8 + 4), s0 = *(const f32x4*)(psin + (size_t)pos * 8), s1 = *(const f32x4*)(psin + (size_t)pos * 8 + 4);
        const float cc[8] = {c0[0], c0[1], c0[2], c0[3], c1[0], c1[1], c1[2], c1[3]}; const float sn[8] = {s0[0], s0[1], s0[2], s0[3], s1[0], s1[1], s1[2], s1[3]};
        u32x4 oa, ob;
#pragma unroll
        for (int e = 0; e < 4; ++e) { const float a0 = lo_f(xa[e]), a1 = hi_f(xa[e]), b0 = lo_f(xb[e]), b1 = hi_f(xb[e]);
            oa[e] = pk2((a0 * cc[2 * e] - b0 * sn[2 * e]) * sc, (a1 * cc[2 * e + 1] - b1 * sn[2 * e + 1]) * sc); ob[e] = pk2((a0 * sn[2 * e] + b0 * cc[2 * e]) * sc, (a1 * sn[2 * e + 1] + b1 * cc[2 * e + 1]) * sc); }
        *(u32x4*)p = oa; *(u32x4*)(p + 8) = ob;
        if (isq) {
#pragma unroll
            for (int c = 2; c < 8; ++c) { u32x4 x = *(const u32x4*)(p + 8 * c);
#pragma unroll
                for (int e = 0; e < 4; ++e) x[e] = pk2(lo_f(x[e]) * sc, hi_f(x[e]) * sc);
                *(u32x4*)(p + 8 * c) = x; } }
    }
    const int gw = C.blk * 8 + C.wave, NGW = C.G * 8;
    for (int wt = gw; wt < (MG / 64) * 8; wt += NGW) { const int tok = (wt >> 3) * 64 + C.lane, dc = wt & 7, bb = tok / T, pos = tok % T;
        const u32x4 xv = *(const u32x4*)(proj + (size_t)tok * NPROJ + C_DV + 8 * dc);
#pragma unroll
        for (int e = 0; e < 4; ++e) { vT[((size_t)bb * 64 + 8 * dc + 2 * e) * T + pos] = (bf16)(xv[e] & 0xffffu); vT[((size_t)bb * 64 + 8 * dc + 2 * e + 1) * T + pos] = (bf16)(xv[e] >> 16); } }
}
DI void dsa_select_item(const Ctx& C, int item) {
    unsigned char* const ws = kargs()->ws;
    const bf16* proj = (const bf16*)(ws + WS_PROJ); unsigned* maskg = (unsigned*)(ws + WS_MASK);
    const int q0 = item * 16, bb = q0 / T, t0 = q0 % T;
    constexpr int SCS = 2083;
    LAS float* SC = (LAS float*)C.lds;
    const int fr = C.lane & 15, fq = C.lane >> 4;
    bf16x8 bq[4][2]; float wq[4];
#pragma unroll
    for (int hh = 0; hh < 4; ++hh) {
#pragma unroll
        for (int s = 0; s < 2; ++s) bq[hh][s] = *(const bf16x8*)(proj + (size_t)(q0 + fr) * NPROJ + C_DQI + 64 * hh + 32 * s + 8 * fq);
        wq[hh] = bf2f(proj[(size_t)(q0 + fr) * NPROJ + C_DWI + hh]) * 0.0625f;
    }
    const int ntile = (t0 + 15) / 16 + 1;
    const bf16* kbase = proj + ((size_t)bb * T + fr) * NPROJ + C_DKI + 8 * fq;
    __syncthreads();
    REPX(40)
#pragma unroll 1
    for (int i0 = C.wave; i0 < ntile; i0 += 32) {
        bf16x8 a[4][2];
#pragma unroll
        for (int u = 0; u < 4; ++u) { const int i = i0 + 8 * u; const int ic = i < ntile ? i : i0;
            a[u][0] = *(const bf16x8*)(kbase + (size_t)ic * 16 * NPROJ); a[u][1] = *(const bf16x8*)(kbase + (size_t)ic * 16 * NPROJ + 32); }
#pragma unroll
        for (int u = 0; u < 4; ++u) { const int i = i0 + 8 * u;
            if (i < ntile) {
                f32x4 sc = {0.f, 0.f, 0.f, 0.f};
#pragma unroll
                for (int hh = 0; hh < 4; ++hh) { f32x4 acc = {0.f, 0.f, 0.f, 0.f}; acc = MFMA16(a[u][0], bq[hh][0], acc); acc = MFMA16(a[u][1], bq[hh][1], acc);
#pragma unroll
                    for (int j = 0; j < 4; ++j) sc[j] += wq[hh] * fmaxf(acc[j], 0.f); }
                const int key0 = 16 * i + 4 * fq;
#pragma unroll
                for (int j = 0; j < 4; ++j) { sc[j] += 0.f; if (key0 + j > t0 + fr) sc[j] = NEG_BIG; SC[fr * SCS + ((key0 + j) & 31) * 65 + (key0 >> 5)] = sc[j]; }
            } }
    }
    __syncthreads();
    LAS unsigned* hist = (LAS unsigned*)(C.lds + 16 * SCS * 4) + C.wave * 320;
    const unsigned dummy = 256u + (unsigned)C.lane;
#pragma unroll 1
    for (int qq = 0; qq < 2; ++qq) {
        const int q = C.wave + 8 * qq, p = t0 + q;
        unsigned* mrow = maskg + (size_t)(q0 + q) * 64;
        const int pl = p - 32 * C.lane;
        if ((p + 1) <= 256) { mrow[C.lane] = pl >= 31 ? 0xffffffffu : (pl < 0 ? 0u : ((2u << pl) - 1u)); continue; }
        unsigned u[32];
#pragma unroll
        for (int j = 0; j < 32; ++j) { unsigned x = 0u;
            if (j <= pl) { x = __float_as_uint(SC[q * SCS + j * 65 + C.lane]); x = (x & 0x80000000u) ? ~x : (x | 0x80000000u); }
            u[j] = x; }
        unsigned prefix = 0u; int remaining = 256, cnt_eq = 0;
#pragma unroll 1
        for (int pass = 0; pass < 4; ++pass) {
            const int shift = 24 - 8 * pass; const unsigned himask = pass == 0 ? 0u : (0xffffffffu << (shift + 8));
            *(LAS u32x4*)(hist + 4 * C.lane) = (u32x4){0u, 0u, 0u, 0u};
            LDS_WAIT();
            if (pass < 2) {
#pragma unroll
                for (int j = 0; j < 32; ++j) { const bool cand = (u[j] != 0u) & (((u[j] ^ prefix) & himask) == 0u);
                    __hip_atomic_fetch_add(hist + (cand ? ((u[j] >> shift) & 255u) : dummy), 1u, __ATOMIC_RELAXED, __HIP_MEMORY_SCOPE_WORKGROUP); }
            } else {
#pragma unroll
                for (int j = 0; j < 32; ++j) { if ((u[j] != 0u) & (((u[j] ^ prefix) & himask) == 0u)) __hip_atomic_fetch_add(hist + ((u[j] >> shift) & 255u), 1u, __ATOMIC_RELAXED, __HIP_MEMORY_SCOPE_WORKGROUP); }
            }
            LDS_WAIT();
            const u32x4 cn = *(const LAS u32x4*)(hist + 4 * C.lane);
            const int tl = (int)(cn[0] + cn[1] + cn[2] + cn[3]);
            int v = tl;
            v += dppi<0x111>(v); v += dppi<0x112>(v); v += dppi<0x114>(v); v += dppi<0x118>(v);
            const int r0 = __builtin_amdgcn_readlane(v, 15), r1 = __builtin_amdgcn_readlane(v, 31), r2 = __builtin_amdgcn_readlane(v, 47), r3 = __builtin_amdgcn_readlane(v, 63);
            const int row = C.lane >> 4; v += (row >= 1 ? r0 : 0) + (row >= 2 ? r1 : 0) + (row >= 3 ? r2 : 0);
            const int total = r0 + r1 + r2 + r3;
            const int suf = total - v + tl;
            const unsigned long long bm = __ballot(suf >= remaining);
            const int L = 63 - __builtin_clzll(bm);
            const int above = __builtin_amdgcn_readlane(suf - tl, L);
            const int c3 = __builtin_amdgcn_readlane((int)cn[3], L), c2 = __builtin_amdgcn_readlane((int)cn[2], L), c1 = __builtin_amdgcn_readlane((int)cn[1], L), c0 = __builtin_amdgcn_readlane((int)cn[0], L);
            int acc = above, dig;
            if (acc + c3 >= remaining) { dig = 3; cnt_eq = c3; } else { acc += c3; if (acc + c2 >= remaining) { dig = 2; cnt_eq = c2; } else { acc += c2; if (acc + c1 >= remaining) { dig = 1; cnt_eq = c1; } else { acc += c1; dig = 0; cnt_eq = c0; } } }
            remaining -= acc; prefix |= (unsigned)(4 * L + dig) << shift;
        }
        const unsigned thr = prefix; const int need = remaining;
        unsigned bits = 0u; unsigned one = 1u; asm volatile("" : "+v"(one));
        if (need >= cnt_eq) {
#pragma unroll
            for (int j = 0; j < 32; ++j) bits |= (u[j] >= thr ? one : 0u) << j;
        } else {
            int tc = 0;
#pragma unroll
            for (int j = 0; j < 32; ++j) tc += (u[j] == thr) ? 1 : 0;
            int v = tc; v += dppi<0x111>(v); v += dppi<0x112>(v); v += dppi<0x114>(v); v += dppi<0x118>(v);
            const int r0 = __builtin_amdgcn_readlane(v, 15), r1 = __builtin_amdgcn_readlane(v, 31), r2 = __builtin_amdgcn_readlane(v, 47);
            const int row = C.lane >> 4; v += (row >= 1 ? r0 : 0) + (row >= 2 ? r1 : 0) + (row >= 3 ? r2 : 0);
            int rank = v - tc;
#pragma unroll
            for (int j = 0; j < 32; ++j) { const bool tie = u[j] == thr; bits |= ((u[j] > thr || (tie && rank < need)) ? one : 0u) << j; rank += tie ? 1 : 0; }
        }
        mrow[C.lane] = bits;
    }
}
DI void dsa_attn_item(const Ctx& C, int bbh, int qt) {
    unsigned char* const ws = kargs()->ws;
    const bf16* proj = (const bf16*)(ws + WS_PROJ); const unsigned* maskg = (const unsigned*)(ws + WS_MASK); bf16* ydsa = (bf16*)(ws + WS_YDR); const bf16* vT = (const bf16*)(ws + WS_VT);
    constexpr int PST = 144;
    ldsp KR = C.lds, VR = C.lds + 16384, PW = C.lds + 32768 + C.wave * (32 * PST);
    const int t0 = qt * 32; const size_t qrow0 = (size_t)bbh * T + t0; const int lr = C.lane & 31, hi = C.lane >> 5, hh = C.wave;
    bf16x8 bq[4];
#pragma unroll
    for (int s = 0; s < 4; ++s) bq[s] = *(const bf16x8*)(proj + (qrow0 + lr) * NPROJ + C_DQ + 64 * hh + 16 * s + 8 * hi);
    f32x16 o0, o1;
#pragma unroll
    for (int r = 0; r < 16; ++r) { o0[r] = 0.f; o1[r] = 0.f; }
    float mrun = -1e20f, lrun = 0.f;
    const unsigned* mrow = maskg + (qrow0 + lr) * 64;
    const int nkt = (t0 + 31) / 64 + 1;
    const bf16* kbase = proj + (size_t)bbh * T * NPROJ + C_DK; const bf16* vbase = vT + (size_t)bbh * 64 * T;
    __syncthreads();
    dma_tile64<64>(KR, kbase, NPROJ, C.wave, C.lane); dma_tile64<64>(VR, vbase, T, C.wave, C.lane);
    unsigned mw0 = mrow[0], mw1 = mrow[1];
    for (int kt = 0; kt < nkt; ++kt) {
        VM_WAIT(); __syncthreads();
        const unsigned cw0 = mw0, cw1 = mw1;
        if (kt + 1 < nkt) { mw0 = mrow[2 * kt + 2]; mw1 = mrow[2 * kt + 3];
            dma_tile64<64>(KR + ((kt + 1) & 1) * 8192, kbase + (size_t)(kt + 1) * 64 * NPROJ, NPROJ, C.wave, C.lane); dma_tile64<64>(VR + ((kt + 1) & 1) * 8192, vbase + (kt + 1) * 64, T, C.wave, C.lane); }
        ldsp KT = KR + (kt & 1) * 8192, VT = VR + (kt & 1) * 8192;
        f32x16 p0, p1;
#pragma unroll
        for (int r = 0; r < 16; ++r) { p0[r] = 0.f; p1[r] = 0.f; }
#pragma unroll
        for (int s = 0; s < 4; ++s) { p0 = MFMA32(frag_sw(KT, lr, 2 * s + hi), bq[s], p0); p1 = MFMA32(frag_sw(KT, 32 + lr, 2 * s + hi), bq[s], p1); }
        const unsigned s0 = cw0 >> (4 * hi), s1 = cw1 >> (4 * hi); float mx = -1e20f;
#pragma unroll
        for (int r = 0; r < 16; ++r) { const unsigned bp = (unsigned)((r & 3) + 8 * (r >> 2)); const unsigned m0 = (unsigned)__builtin_amdgcn_sbfe((int)s0, bp, 1u), m1 = (unsigned)__builtin_amdgcn_sbfe((int)s1, bp, 1u);
            p0[r] = __uint_as_float((__float_as_uint(p0[r]) & m0) | (0xf149f2cau & ~m0)); p1[r] = __uint_as_float((__float_as_uint(p1[r]) & m1) | (0xf149f2cau & ~m1));
            mx = fmaxf(mx, fmaxf(p0[r], p1[r])); }
        mx = swap32_max(mx);
        if (!__all(mx - mrun <= 8.f)) { const float mnew = fmaxf(mrun, mx); const float alpha = __builtin_amdgcn_exp2f(mrun - mnew); mrun = mnew; lrun *= alpha;
#pragma unroll
            for (int r = 0; r < 16; ++r) { o0[r] *= alpha; o1[r] *= alpha; } }
        float ps = 0.f;
#pragma unroll
        for (int r = 0; r < 16; ++r) { p0[r] = __builtin_amdgcn_exp2f(p0[r] - mrun); p1[r] = __builtin_amdgcn_exp2f(p1[r] - mrun); ps += p0[r] + p1[r]; }
        lrun += ps;
#pragma unroll
        for (int g = 0; g < 4; ++g) { u32x2 w0, w1; w0.x = pk2(p0[4 * g], p0[4 * g + 1]); w0.y = pk2(p0[4 * g + 2], p0[4 * g + 3]); w1.x = pk2(p1[4 * g], p1[4 * g + 1]); w1.y = pk2(p1[4 * g + 2], p1[4 * g + 3]);
            *(LAS u32x2*)(PW + lr * PST + (8 * g + 4 * hi) * 2) = w0; *(LAS u32x2*)(PW + lr * PST + (32 + 8 * g + 4 * hi) * 2) = w1; }
        LDS_WAIT();
#pragma unroll
        for (int s = 0; s < 4; ++s) { const bf16x8 pf = lds_frag(PW + lr * PST + (16 * s + 8 * hi) * 2);
            o0 = MFMA32(frag_sw(VT, lr, 2 * s + hi), pf, o0); o1 = MFMA32(frag_sw(VT, 32 + lr, 2 * s + hi), pf, o1); }
    }
    const float linv = __builtin_amdgcn_rcpf(swap32_sum(lrun));
    bf16* yo = ydsa + (qrow0 + lr) * 1024 + hh * 64;
#pragma unroll
    for (int g = 0; g < 4; ++g) { u32x2 w0, w1; w0.x = pkh2(o0[4 * g] * linv, o0[4 * g + 1] * linv); w0.y = pkh2(o0[4 * g + 2] * linv, o0[4 * g + 3] * linv);
        w1.x = pkh2(o1[4 * g] * linv, o1[4 * g + 1] * linv); w1.y = pkh2(o1[4 * g + 2] * linv, o1[4 * g + 3] * linv);
        *(u32x2*)(yo + 8 * g + 4 * hi) = w0; *(u32x2*)(yo + 32 + 8 * g + 4 * hi) = w1; }
}

DI void final_norm(const Ctx& C, const float* gain, const float* ss) {
    const kargp ap = kargs(); float* const out = ap->out; const bf16* x16 = (const bf16*)(ap->ws + WS_XB);
    const int gw = C.blk * 8 + C.wave, NGW = C.G * 8;
    f32x4 gv[4];
#pragma unroll
    for (int j = 0; j < 4; ++j) gv[j] = *((const f32x4*)gain + C.lane + 64 * j);
    for (int m0 = gw; m0 < M; m0 += 4 * NGW) {
        u32x2 v[4][4]; float rs[4];
#pragma unroll
        for (int r = 0; r < 4; ++r) { const int m = m0 + r * NGW; const int mc = m < M ? m : m0; rs[r] = pg8::rstd_of(ss + (size_t)mc * 16); const u32x2* xr = (const u32x2*)(x16 + (size_t)mc * D) + C.lane;
#pragma unroll
            for (int j = 0; j < 4; ++j) v[r][j] = xr[64 * j]; }
#pragma unroll
        for (int r = 0; r < 4; ++r) { const int m = m0 + r * NGW; if (m < M) { f32x4* xo = (f32x4*)(out + (size_t)m * D) + C.lane;
#pragma unroll
            for (int j = 0; j < 4; ++j) { const f32x4 x = {hlo_f(v[r][j].x), hhi_f(v[r][j].x), hlo_f(v[r][j].y), hhi_f(v[r][j].y)}; xo[64 * j] = x * rs[r] * gv[j]; } } }
    }
}

#ifndef PH_MASK
#define PH_MASK 0xFFFF
#endif
#define PH(b) if constexpr ((PH_MASK >> (b)) & 1)
#ifndef DUP_PHASE
#define DUP_PHASE -1
#endif
#define REP(k) for (int rep = 0; rep < ((DUP_PHASE == (k)) ? 2 : 1); ++rep)
__global__ void __launch_bounds__(512, 2) fwd_kernel(Args a_unused) {
    extern __shared__ __attribute__((aligned(16))) unsigned char lds_raw[];
    Ctx C; C.lds = (ldsp)lds_raw; C.tid = threadIdx.x; C.lane = C.tid & 63; C.wave = __builtin_amdgcn_readfirstlane(C.tid >> 6); C.G = gridDim.x; C.blk = blockIdx.x;
    volatile LAS unsigned* MISC = (volatile LAS unsigned*)(C.lds + MISC_OFF);
    if (C.tid < 64) MISC[C.tid] = 0u;
    __syncthreads();
    XcdBarrier bar = xcd_barrier_post((unsigned*)(kargs()->ws + WS_CTL) + CW_BAR, MISC + 8);
#define GRID_BAR() xcd_barrier(bar)
#define WSP() (kargs()->ws)
#define SSP(ws_, idx) ((float*)((ws_) + WS_SS) + (size_t)(idx) * (SS_BYTES / 4))
#define TABP(ws_, off) ((const float*)((ws_) + WS_TAB) + (off) / 4)

    REP(0) { PH(0) { const Ctx Cp = fresh(C); p0_prologue(Cp); }
    GRID_BAR(); }

#pragma unroll 1
    for (int hl = 0; hl < 2 * DEPTH; ++hl) {
        const int l = hl >> 1; const bool isB = hl & 1;
        REP(1) { PH(1) { const Ctx Cp = fresh(C);
            unsigned char* const ws = WSP(); const bf16* wl = (const bf16*)(ws + WS_W + (size_t)l * W_LAYER_BYTES);
            pg8::Gemm g{(const bf16*)(ws + WS_XB), wl + (isB ? WO_FFB_IN : WO_FFA_IN), M, 2 * DFF, D}; pg8::StaticOrder S; S.init(M, 2 * DFF, Cp.G, Cp.blk);
            pg8::EpiSwiglu E{(bf16*)(ws + WS_ACT), SSP(ws, isB ? 3 * l + 2 : 3 * l)};
#ifdef PROBE_NULL_EPI
            if (rep) { pg8::EpiNull EN{(float*)(ws + WS_CTL) + 8192}; pg8::gemm_phase<pg8::EpiNull, pg8::StaticOrder, PG8_ALIGN, PG8_SP2>(Cp.lds, g, S, EN, Cp.tid); } else
#endif
            pg8::gemm_phase<pg8::EpiSwiglu, pg8::StaticOrder, PG8_ALIGN, PG8_SP2>(Cp.lds, g, S, E, Cp.tid);
        }
        GRID_BAR(); }
        REP(2) { PH(2) { const Ctx Cp = fresh(C);
            const kargp ap = kargs(); unsigned char* const ws = ap->ws; float* const out = ap->out; const bf16* wl = (const bf16*)(ws + WS_W + (size_t)l * W_LAYER_BYTES);
            pg8::Gemm g{(const bf16*)(ws + WS_ACT), wl + (isB ? WO_FFB_OUT : WO_FFA_OUT), M, D, DFF}; pg8::StaticOrder S; S.init(M, D, Cp.G, Cp.blk);
            pg8::EpiResid E{(bf16*)(ws + WS_XB), SSP(ws, isB ? 3 * l + 3 : 3 * l + 1), rep ? 0.f : 0.5f, 0};
            pg8::gemm_phase<pg8::EpiResid, pg8::StaticOrder, PG8_ALIGN, PG8_SP2, true>(Cp.lds, g, S, E, Cp.tid);
        }
        GRID_BAR(); }
        if (isB) continue;
#pragma unroll 1
        for (int st = 0; st <= NG; ++st) {
            if (st >= 1) {
            const int grp = st - 1; const size_t grow = (size_t)grp * MG;
            REP(30) {
                REP(13) PH(6) { const Ctx Cp = fresh(C); const kargp ap = kargs(); const bf16* wl = (const bf16*)(ap->ws + WS_W + (size_t)l * W_LAYER_BYTES);
                    RwkvP P{ap->in[I_MU] + l * 1792, ap->in[I_W0] + l * 512, ap->in[I_A0] + l * 512, ap->in[I_KK] + l * 512, ap->in[I_KA] + l * 512, ap->in[I_RK] + l * 512, wl + WO_W2T, wl + WO_A2T, wl + WO_G2T};
                    for (int it = Cp.blk; it < NCHAIN * NRCH; it += Cp.G) rwkv_pre_item(Cp, P, it); }
                REP(7) PH(7) { const Ctx Cp = fresh(C); unsigned char* const ws = WSP(); for (int it = Cp.blk; it < BG * 8 * 15; it += Cp.G) ret_state_item(Cp, it / 15, it % 15, TABP(ws, TAB_RCOS), TABP(ws, TAB_RSIN)); }
            GRID_BAR(); }
            REP(31) {
                PH(7) { const Ctx Cp = fresh(C); ret_scan(Cp); }
                if (C.blk < NCHAIN) { REP(16) PH(6) { const Ctx Cp = fresh(C); rwkv_state_chain(Cp, Cp.blk); } }
                REP(14) PH(8) { const Ctx Cp = fresh(C);
                    constexpr int NU = MG / 16;
                    unsigned* const ctr = (unsigned*)(kargs()->ws + WS_CTL) + CW_QUEUE + (((l * NG + grp) * 2 + 0) * 2 + rep) * 64;
                    volatile LAS unsigned* QS = (volatile LAS unsigned*)(Cp.lds + MISC_OFF) + 16;
                    if (Cp.tid == 0) QS[0] = __hip_atomic_fetch_add(ctr, 1u, __ATOMIC_RELAXED, __HIP_MEMORY_SCOPE_AGENT);
                    __syncthreads();
                    unsigned it = QS[0]; int slot = 1;
                    while (it < (unsigned)NU) {
                        unsigned nxt = 0u; if (Cp.tid == 0) nxt = __hip_atomic_fetch_add(ctr, 1u, __ATOMIC_RELAXED, __HIP_MEMORY_SCOPE_AGENT);
                        { REPX(20) dsa_select_item(Cp, (int)(it & 3u) * (T / 16) + (T / 16 - 1) - (int)(it >> 2)); }
                        if (Cp.tid == 0) QS[slot] = nxt;
                        __syncthreads();
                        it = QS[slot]; slot ^= 1; } }
            GRID_BAR(); }
            REP(32) {
                REP(15) PH(8) { const Ctx Cp = fresh(C); const int idx = Cp.blk; if (idx < BG * 64) dsa_attn_item(Cp, idx & 3, 63 - (idx >> 2)); }
                REP(9) PH(9) { const Ctx Cp = fresh(C); const kargp ap = kargs(); const float* lnw = ap->in[I_LNW] + l * 512; const float* lnb = ap->in[I_LNB] + l * 512;
                    const int lo = (Cp.blk * Cp.blk + 63) / 64, hi = ((Cp.blk + 1) * (Cp.blk + 1) + 63) / 64;
                    { REPX(22) rwkv_out_items(Cp, lo, hi < NCHAIN * NRCH ? hi : NCHAIN * NRCH, lnw, lnb); }
                    { const int rlo = (lo + 1) / 2, rhi = (hi + 1) / 2; REPX(21) ret_out_items(Cp, rlo, rhi < BG * 8 * 16 ? rhi : BG * 8 * 16); } }
            GRID_BAR(); }
            REP(10) { PH(10) {
                const Ctx Cp = fresh(C); unsigned char* const ws = WSP(); const bf16* wl = (const bf16*)(ws + WS_W + (size_t)l * W_LAYER_BYTES);
                pg8::MergeSched S{(const char*)(ws + WS_YRET), (const char*)(ws + WS_YDR), (const char*)(wl + WO_PRET), (const char*)(wl + WO_PDR), (MG / 256) * (D / 128), Cp.blk, D / 128};
                pg8::EpiMerge3 E{}; E.proj = (const bf16*)(ws + WS_PROJ); E.merged = (bf16*)(ws + WS_MERGED);
                pg8::gemm_nhalf_phase<pg8::EpiMerge3, pg8::MergeSched, 1024>(Cp.lds, S, E, Cp.tid);
            }
            GRID_BAR(); }
            REP(11) { PH(11) {
                if (C.blk >= (C.G >> 1)) { const Ctx Cp = fresh(C);
                unsigned char* const ws = WSP(); const bf16* wl = (const bf16*)(ws + WS_W + (size_t)l * W_LAYER_BYTES);
                pg8::Gemm g{(const bf16*)(ws + WS_MERGED), wl + WO_WOUT, MG, D, D}; pg8::StaticOrder S; S.init(MG, D, Cp.G >> 1, Cp.blk - (Cp.G >> 1));
                pg8::EpiResid E{(bf16*)(ws + WS_XB), SSP(ws, 3 * l + 2), rep ? 0.f : 1.0f, (int)grow};
                pg8::gemm_phase<pg8::EpiResid, pg8::StaticOrder, PG8_ALIGN, PG8_SP2>(Cp.lds, g, S, E, Cp.tid); }
            }
            }
            }
            if (st < NG) {
            const size_t grow = (size_t)st * MG;
            REP(3) { PH(3) {
                const Ctx Cp = fresh(C);
                unsigned char* const ws = WSP(); const bf16* wl = (const bf16*)(ws + WS_W + (size_t)l * W_LAYER_BYTES);
                pg8::Gemm g{(const bf16*)(ws + WS_XB) + grow * D, wl + WO_WIN, MG, NPROJ, D}; pg8::StaticOrder S; S.init(MG, NPROJ, Cp.G, Cp.blk);
                pg8::EpiProj E{(bf16*)(ws + WS_PROJ), SSP(ws, 3 * l + 1) + grow * 16, TABP(ws, TAB_RCOS), TABP(ws, TAB_RSIN), TABP(ws, TAB_PCOS), TABP(ws, TAB_PSIN), (bf16*)(ws + WS_VT)};
                pg8::gemm_phase<pg8::EpiProj, pg8::StaticOrder, PG8_ALIGN, PG8_SP2>(Cp.lds, g, S, E, Cp.tid);
            }
            }
            }
            GRID_BAR();
        }
    }
    PH(12) { const Ctx Cp = fresh(C); const kargp ap = kargs(); final_norm(Cp, ap->in[I_NORM_FINAL], SSP(ap->ws, 6)); }
}

extern "C" void kernel_launch(void* const* d_in, const int* in_sizes, int n_in, void* d_out, int out_size, void* d_ws, size_t ws_size, hipStream_t stream) {
    static int grid = 0;
    if (grid == 0) {
        if (n_in != 25 || out_size != M * D || ws_size < WS_END || ws_size < WS_ACT + (size_t)M * DFF * 2) { fprintf(stderr, "kernel_launch: unexpected problem (n_in %d out %d ws %zu)\n", n_in, out_size, ws_size); grid = -1; return; }
        int dev = 0, cus = 0, per_cu = 0;
        if (hipGetDevice(&dev) != hipSuccess || hipDeviceGetAttribute(&cus, hipDeviceAttributeMultiprocessorCount, dev) != hipSuccess) { grid = -1; return; }
        if (hipFuncSetAttribute((const void*)fwd_kernel, hipFuncAttributeMaxDynamicSharedMemorySize, LDS_BYTES) != hipSuccess) { fprintf(stderr, "kernel_launch: hipFuncSetAttribute failed\n"); grid = -1; return; }
        if (hipOccupancyMaxActiveBlocksPerMultiprocessor(&per_cu, (const void*)fwd_kernel, 512, LDS_BYTES) != hipSuccess || per_cu < 1) fprintf(stderr, "kernel_launch: occupancy query reports %d\n", per_cu);
        (void)hipGetLastError();
        grid = cus;
        if (grid != 256) fprintf(stderr, "kernel_launch: %d CUs (built for 256)\n", grid);
    }
    if (grid < 0) return;
    (void)in_sizes;
    hipMemsetAsync((char*)d_ws + WS_CTL, 0, CTL_ZERO_BYTES, stream);
    Args a{};
    for (int i = 0; i < 25; ++i) a.in[i] = (const float*)d_in[i];
    a.out = (float*)d_out; a.ws = (unsigned char*)d_ws;
    for (int i = 0; i < 32; ++i) a.inv_ret[i] = powf(10000.0f, -(float)(2 * i) / 64.0f);
    for (int i = 0; i < 8; ++i) a.inv_rot[i] = powf(500000.0f, -(float)(2 * i) / 16.0f);
    hipLaunchKernelGGL(fwd_kernel, dim3(grid), dim3(512), LDS_BYTES, stream, a);
}
```
